# Optimizing an MI355X kernel written in HIP

```python
import jax, jax.numpy as jnp
from jax import lax
import numpy as np

D_MODEL = 2048
BATCH = 2
SEQ = 4096
DEPTH = 2

N_MIXERS = 2
HGRN_EXPAND = 128
HGRN_HEADS = D_MODEL // HGRN_EXPAND
HGRN_F_DIM = HGRN_HEADS * HGRN_EXPAND
HGRN_I_DIM = D_MODEL
HGRN_HEAD_I = HGRN_I_DIM // HGRN_HEADS
CHUNK = 64
CONV_WIDTH = 3
D_FF = 5632
EPS = 1e-6
N_HGRN = (DEPTH + 1) // 2
N_SC = DEPTH // 2

kernel_name = "hgrn2_shortconv_interleaved_trunk"


def rms_norm(x, w):
    x32 = x.astype(jnp.float32)
    y = x32 * lax.rsqrt(jnp.mean(x32 * x32, axis=-1, keepdims=True) + EPS)
    return (y * w.astype(jnp.float32)).astype(x.dtype)


def causal_dwconv(u, w):
    K = w.shape[0]
    T = u.shape[1]
    up = jnp.pad(u, ((0, 0), (K - 1, 0), (0, 0)))
    return sum(up[:, k:k + T] * w[k] for k in range(K))


def chunked_gated_recurrence(q, k, v, logf):
    B, T, H, dk = q.shape
    dv = v.shape[-1]
    n = T // CHUNK

    def to_chunks(a):
        return a.reshape(B, n, CHUNK, H, a.shape[-1]).transpose(1, 0, 3, 2, 4)

    causal = jnp.tril(jnp.ones((CHUNK, CHUNK), dtype=bool))

    def step(S, inp):
        qc, kc, vc, gc = inp
        b = jnp.cumsum(gc, axis=2)
        rel = b[:, :, :, None, :] - b[:, :, None, :, :]
        rel = jnp.where(causal[:, :, None], rel, -jnp.inf)
        A = jnp.einsum('bhtd,bhsd,bhtsd->bhts', qc, kc, jnp.exp(rel))
        o = jnp.einsum('bhts,bhsv->bhtv', A, vc) + jnp.einsum('bhtd,bhdv->bhtv', qc * jnp.exp(b), S)
        b_last = b[:, :, -1:, :]
        S = jnp.exp(b_last[:, :, 0, :])[..., None] * S + jnp.einsum(
            'bhsd,bhsv->bhdv', kc * jnp.exp(b_last - b), vc)
        return S, o

    S0 = jnp.zeros((B, H, dk, dv), jnp.float32)
    _, o = lax.scan(step, S0, (to_chunks(q), to_chunks(k), to_chunks(v), to_chunks(logf)))
    return o.transpose(1, 0, 3, 2, 4).reshape(B, T, H * dv)


def hgrn2_mixer(xn, w_in, lb, out_gain, w_out):
    B, T, _ = xn.shape
    proj = xn @ w_in
    q, fr, v, g = jnp.split(proj, [HGRN_F_DIM, 2 * HGRN_F_DIM, 2 * HGRN_F_DIM + HGRN_I_DIM], axis=-1)
    q = jax.nn.silu(q.astype(jnp.float32)) * (HGRN_EXPAND ** -0.5)
    f = lb + (1.0 - lb) * jax.nn.sigmoid(fr.astype(jnp.float32))
    k = 1.0 - f
    logf = jnp.log(f)

    def heads(a, d):
        return a.reshape(B, T, HGRN_HEADS, d).astype(jnp.float32)

    o = chunked_gated_recurrence(heads(q, HGRN_EXPAND), heads(k, HGRN_EXPAND),
                                 heads(v, HGRN_HEAD_I), heads(logf, HGRN_EXPAND))
    o = rms_norm(o, out_gain) * jax.nn.silu(g.astype(jnp.float32))
    return (o @ w_out.astype(jnp.float32)).astype(xn.dtype)


def short_conv_mixer(xn, w_in, conv_w, w_out):
    proj = xn @ w_in
    gb, gc, h = jnp.split(proj, 3, axis=-1)
    y = gb * causal_dwconv(gc * h, conv_w)
    return y @ w_out


def conv_glu_ffn(xn, w_up, conv_w, w_down):
    u = causal_dwconv(xn @ w_up, conv_w)
    gate, val = jnp.split(u, 2, axis=-1)
    return (jax.nn.silu(gate) * val) @ w_down


def setup_inputs(seed: int = 0) -> dict:
    key = jax.random.key(seed)
    ks = jax.random.split(key, 16)
    f32 = jnp.float32

    def w(k, shape, fan_in):
        return jax.random.normal(k, shape, f32) * (fan_in ** -0.5)

    def gain(k, shape):
        return 1.0 + 0.02 * jax.random.normal(k, shape, f32)

    return {
        "x": jax.random.normal(ks[0], (BATCH, SEQ, D_MODEL), f32),
        "norm_mix": gain(ks[1], (DEPTH, D_MODEL)),
        "norm_ffn": gain(ks[2], (DEPTH, D_MODEL)),
        "hgrn_w_in": w(ks[3], (N_HGRN, D_MODEL, 2 * HGRN_F_DIM + 2 * HGRN_I_DIM), D_MODEL),
        "hgrn_lb_table": 0.1 * jax.random.normal(ks[4], (DEPTH + 1, HGRN_F_DIM), f32),
        "hgrn_out_norm": gain(ks[5], (N_HGRN, HGRN_I_DIM)),
        "hgrn_w_out": w(ks[6], (N_HGRN, HGRN_I_DIM, D_MODEL), HGRN_I_DIM),
        "sc_w_in": w(ks[7], (N_SC, D_MODEL, 3 * D_MODEL), D_MODEL),
        "sc_conv": w(ks[8], (N_SC, CONV_WIDTH, D_MODEL), CONV_WIDTH),
        "sc_w_out": w(ks[9], (N_SC, D_MODEL, D_MODEL), D_MODEL),
        "ffn_w_up": w(ks[10], (DEPTH, D_MODEL, 2 * D_FF), D_MODEL),
        "ffn_conv": w(ks[11], (DEPTH, CONV_WIDTH, 2 * D_FF), CONV_WIDTH),
        "ffn_w_down": w(ks[12], (DEPTH, D_FF, D_MODEL), D_FF),
        "final_norm": gain(ks[13], (D_MODEL,)),
    }


def reference(x, norm_mix, norm_ffn, hgrn_w_in, hgrn_lb_table, hgrn_out_norm, hgrn_w_out,
              sc_w_in, sc_conv, sc_w_out, ffn_w_up, ffn_conv, ffn_w_down, final_norm):
    lb_all = jnp.cumsum(jax.nn.softmax(hgrn_lb_table.astype(jnp.float32), axis=0), axis=0)
    h = x
    for i in range(DEPTH):
        j = i // N_MIXERS
        xn = rms_norm(h, norm_mix[i])
        if i % N_MIXERS == 0:
            mix = hgrn2_mixer(xn, hgrn_w_in[j], lb_all[i], hgrn_out_norm[j], hgrn_w_out[j])
        else:
            mix = short_conv_mixer(xn, sc_w_in[j], sc_conv[j], sc_w_out[j])
        h = h + mix.astype(h.dtype)
        h = h + conv_glu_ffn(rms_norm(h, norm_ffn[i]), ffn_w_up[i], ffn_conv[i], ffn_w_down[i]).astype(h.dtype)
    return rms_norm(h, final_norm)
```

```cpp
#include <hip/hip_runtime.h>
#include <hip/hip_cooperative_groups.h>
#include <cstdio>
#include <cstdint>
namespace cg = cooperative_groups;
#ifndef MK_SINGLE
#define MK_SINGLE 1
#endif
namespace pg8 {
#define PG8_LAS __attribute__((address_space(3)))
typedef unsigned short bf16_t;
typedef short bf16x8 __attribute__((ext_vector_type(8)));
typedef float f32x4 __attribute__((ext_vector_type(4)));
typedef unsigned u32x4 __attribute__((ext_vector_type(4)));
constexpr int BM = 256, BK = 64, HALF = 128, HTB = HALF * BK * 2  , STAGE_BYTES = 8 * HTB, NXCD = 8, WGM = 8;

__host__ __device__ __forceinline__ int lds_byte(int r, int c) { const int st = (r >> 4) * 2 + (c >> 5), rr = r & 15, cc = c & 31, ob = rr * 64 + cc * 2; return st * 1024 + (ob ^ (((ob >> 9) & 1) << 5)); }
__host__ __device__ __forceinline__ void stage_rc(int b, int& R, int& C) { const int st = b / 1024, sb = b % 1024, swz = sb ^ (((sb >> 9) & 1) << 5); R = (st >> 1) * 16 + swz / 64; C = (st & 1) * 32 + (swz % 64) / 2; }
__host__ __device__ __forceinline__ int perm32(int rho) { const int n = rho >> 4, i = rho & 15; return 8 * (i >> 2) + 4 * n + (i & 3); }

struct Unit { int pm, pn; };
struct Gemm { const bf16_t* A; const bf16_t* Bt; int M, N, K; };

struct StaticOrder {
    int nM, nN, nwg, G, c;
    __host__ __device__ void init(int M, int N, int G_, int c_) { nM = M / BM; nN = N / BM; nwg = nM * nN; G = G_; c = c_; }
    __host__ __device__ bool next(int i, Unit& u) const {
        const long L = (long)i * G + c; if (L >= nwg) return false;
        int wgid = (int)L; { const int q = nwg / NXCD, r = nwg % NXCD, xcd = wgid % NXCD, off = wgid / NXCD; wgid = (xcd < r ? xcd * (q + 1) : r * (q + 1) + (xcd - r) * q) + off; }
        const int nig = WGM * nN, gid = wgid / nig, fm = gid * WGM, gsz = (nM - fm) < WGM ? (nM - fm) : WGM;
        u.pm = fm + ((wgid % nig) % gsz); u.pn = (wgid % nig) / gsz; return true;
    }
    __device__ __forceinline__ void a_ready(const Unit&) const {}
    __device__ __forceinline__ void done(const Unit&) const {}
};
__device__ __forceinline__ unsigned cvt_pk_bf16(float lo, float hi) { unsigned r; asm volatile("v_cvt_pk_bf16_f32 %0, %1, %2" : "=v"(r) : "v"(lo), "v"(hi)); return r; }
template <int mode, int KC_> struct Epi {
    static constexpr bool PERM = true, AFTER_DRAIN = false; static constexpr int KC = KC_;
    bf16_t* O; int ldc;
    float* out; const float* res; const float* ss;
    bf16_t* Q; float* LOGF; bf16_t* V; bf16_t* G; const float* lbt;
    __device__ __forceinline__ void operator()(const f32x4 (&acc)[2][2][4][2], const Unit& u, int wr, int wc, int fr_, int fq_) const {
        int l_; asm volatile("v_mbcnt_lo_u32_b32 %0, -1, 0\n\tv_mbcnt_hi_u32_b32 %0, -1, %0" : "=v"(l_));
        const int fr = l_ & 15, fq = l_ >> 4; (void)fr_; (void)fq_;
        const int row0 = u.pm * BM + wr * 64 + fr;
        if constexpr (mode == 0) {
            const int col0 = u.pn * BM + wc * 32 + 8 * fq;
#pragma unroll
            for (int ai = 0; ai < 2; ++ai)
#pragma unroll
                for (int m = 0; m < 4; ++m) { bf16_t* rowp = O + (size_t)(row0 + ai * HALF + m * 16) * ldc + col0;
#pragma unroll
                    for (int bj = 0; bj < 2; ++bj) { const f32x4 v0 = acc[ai][bj][m][0], v1 = acc[ai][bj][m][1];
                        u32x4 w; w.x = cvt_pk_bf16(v0[0], v0[1]); w.y = cvt_pk_bf16(v0[2], v0[3]); w.z = cvt_pk_bf16(v1[0], v1[1]); w.w = cvt_pk_bf16(v1[2], v1[3]);
                        *(u32x4*)(rowp + bj * HALF) = w; } }
        } else if constexpr (mode == 1) {
            const int col0 = u.pn * BM + wc * 32 + 8 * fq;
#pragma unroll
            for (int ai = 0; ai < 2; ++ai)
#pragma unroll
                for (int m = 0; m < 4; ++m) { const int row = row0 + ai * HALF + m * 16; const size_t off = (size_t)row * 2048 + col0;
                    float sc = 1.0f;
                    if (ss) { const f32x4* sp = (const f32x4*)(ss + (size_t)row * 16); const f32x4 a = sp[0], b = sp[1], c = sp[2], d = sp[3];
                        const float t = ((a[0] + a[1]) + (a[2] + a[3])) + ((b[0] + b[1]) + (b[2] + b[3])) + ((c[0] + c[1]) + (c[2] + c[3])) + ((d[0] + d[1]) + (d[2] + d[3]));
                        sc = __builtin_amdgcn_rsqf(t * (1.0f / 2048.0f) + 1e-6f); }
#pragma unroll
                    for (int bj = 0; bj < 2; ++bj) { const f32x4 r0 = *(const f32x4*)(res + off + bj * HALF), r1 = *(const f32x4*)(res + off + bj * HALF + 4);
                        *(f32x4*)(out + off + bj * HALF) = r0 + acc[ai][bj][m][0] * sc; *(f32x4*)(out + off + bj * HALF + 4) = r1 + acc[ai][bj][m][1] * sc; }
                    asm volatile("" ::: "memory"); }
        } else {
            const int sec = u.pn >> 3, col0 = (u.pn & 7) * BM + wc * 32 + 8 * fq;
            if (sec == 2) {
#pragma unroll
                for (int ai = 0; ai < 2; ++ai)
#pragma unroll
                    for (int m = 0; m < 4; ++m) { bf16_t* rowp = V + (size_t)(row0 + ai * HALF + m * 16) * 2048 + col0;
#pragma unroll
                        for (int bj = 0; bj < 2; ++bj) { const f32x4 v0 = acc[ai][bj][m][0], v1 = acc[ai][bj][m][1];
                            u32x4 w; w.x = cvt_pk_bf16(v0[0], v0[1]); w.y = cvt_pk_bf16(v0[2], v0[3]); w.z = cvt_pk_bf16(v1[0], v1[1]); w.w = cvt_pk_bf16(v1[2], v1[3]);
                            *(u32x4*)(rowp + bj * HALF) = w; } }
            } else if (sec == 1) {
                f32x4 lb[2][2];
#pragma unroll
                for (int bj = 0; bj < 2; ++bj)
#pragma unroll
                    for (int n = 0; n < 2; ++n) { const float* p = lbt + col0 + bj * HALF + 4 * n; const f32x4 t0 = *(const f32x4*)p, t1 = *(const f32x4*)(p + 2048), t2 = *(const f32x4*)(p + 4096);
#pragma unroll
                        for (int j = 0; j < 4; ++j) { const float mx = fmaxf(t0[j], fmaxf(t1[j], t2[j])); const float e0 = __expf(t0[j] - mx), e1 = __expf(t1[j] - mx), e2 = __expf(t2[j] - mx); lb[bj][n][j] = e0 / (e0 + e1 + e2); } }
#pragma unroll
                for (int ai = 0; ai < 2; ++ai)
#pragma unroll
                    for (int m = 0; m < 4; ++m) { float* rowp = LOGF + (size_t)(row0 + ai * HALF + m * 16) * 2048 + col0;
#pragma unroll
                        for (int bj = 0; bj < 2; ++bj)
#pragma unroll
                            for (int n = 0; n < 2; ++n) { f32x4 o;
#pragma unroll
                                for (int j = 0; j < 4; ++j) { const float a = acc[ai][bj][m][n][j]; const float sg = __builtin_amdgcn_rcpf(1.0f + __expf(-a)); const float l = lb[bj][n][j]; o[j] = __logf(l + (1.0f - l) * sg); }
                                *(f32x4*)(rowp + bj * HALF + 4 * n) = o; } }
            } else {
                bf16_t* base = sec == 0 ? Q : G; const float sc = sec == 0 ? 0.08838834764831845f : 1.0f;
#pragma unroll
                for (int ai = 0; ai < 2; ++ai)
#pragma unroll
                    for (int m = 0; m < 4; ++m) { bf16_t* rowp = base + (size_t)(row0 + ai * HALF + m * 16) * 2048 + col0;
#pragma unroll
                        for (int bj = 0; bj < 2; ++bj) { f32x4 v0 = acc[ai][bj][m][0], v1 = acc[ai][bj][m][1];
#pragma unroll
                            for (int j = 0; j < 4; ++j) { v0[j] = v0[j] * sc * __builtin_amdgcn_rcpf(1.0f + __expf(-v0[j])); v1[j] = v1[j] * sc * __builtin_amdgcn_rcpf(1.0f + __expf(-v1[j])); }
                            u32x4 w; w.x = cvt_pk_bf16(v0[0], v0[1]); w.y = cvt_pk_bf16(v0[2], v0[3]); w.z = cvt_pk_bf16(v1[0], v1[1]); w.w = cvt_pk_bf16(v1[2], v1[3]);
                            *(u32x4*)(rowp + bj * HALF) = w; } }
            }
        }
    }
};

template <class Epi, class Sched, bool ALIGN_EPI = false, bool SP2 = false>
__device__ __forceinline__ void gemm_phase(PG8_LAS unsigned char* lds, const Gemm g, const Sched& S, const Epi& E, const int wid) {
    int lane_; asm volatile("v_mbcnt_lo_u32_b32 %0, -1, 0\n\tv_mbcnt_hi_u32_b32 %0, -1, %0" : "=v"(lane_));
    const int lane = lane_, tid = wid * 64 + lane, wr = wid >> 2, wc = wid & 3, fr = lane & 15, fq = lane >> 4;
    constexpr int K = Epi::KC, nt = K / BK;
    unsigned voffA[2], voffB[2];
#pragma unroll
    for (int i = 0; i < 2; ++i) { int R, C; stage_rc(tid * 16 + i * 8192, R, C); const int Rb = Epi::PERM ? ((R & ~31) + perm32(R & 31)) : R;
        voffA[i] = (unsigned)(R * K + C) * 2u; voffB[i] = (unsigned)(Rb * K + C) * 2u; }
    const size_t kstep = (size_t)(BK * 2);
    const size_t hstep = (size_t)HALF * K * 2;
    const size_t tstep = 2 * hstep;
    const unsigned ldsw = (unsigned)wid * 1024u;
    const int aoff = lds_byte(wr * 64 + fr, fq * 8), boff = lds_byte(wc * 32 + fr, fq * 8);
#define PG8_SA(b, h) (((b) * 2 + (h)) * HTB)
#define PG8_SB(b, h) ((4 + (b) * 2 + (h)) * HTB)
#define PG8_STAGE(bufoff, gbase, voff) do { _Pragma("unroll") for (int _i = 0; _i < 2; ++_i) \
        __builtin_amdgcn_global_load_lds((const unsigned*)((const char*)(gbase) + (voff)[_i]), (PG8_LAS unsigned*)(lds + (bufoff) + ldsw + _i * 8192), 16, 0, 0); } while (0)
#define PG8_LDA(dst, b, h) do { _Pragma("unroll") for (int m = 0; m < 4; ++m) _Pragma("unroll") for (int k = 0; k < 2; ++k) dst[m][k] = *(const PG8_LAS bf16x8*)(lds + PG8_SA(b, h) + aoff + m * 2048 + k * 1024); } while (0)
#define PG8_LDB(dst, b, h) do { _Pragma("unroll") for (int n = 0; n < 2; ++n) _Pragma("unroll") for (int k = 0; k < 2; ++k) dst[n][k] = *(const PG8_LAS bf16x8*)(lds + PG8_SB(b, h) + boff + n * 2048 + k * 1024); } while (0)
#define PG8_MMA(ai, bj, At, Bt) do { __builtin_amdgcn_s_setprio(1); _Pragma("unroll") for (int m = 0; m < 4; ++m) _Pragma("unroll") for (int n = 0; n < 2; ++n) _Pragma("unroll") for (int k = 0; k < 2; ++k) \
        acc[ai][bj][m][n] = __builtin_amdgcn_mfma_f32_16x16x32_bf16(Bt[n][k], At[m][k], acc[ai][bj][m][n], 0, 0, 0); __builtin_amdgcn_s_setprio(0); } while (0)
#define PG8_WAIT_V(n) asm volatile("s_waitcnt vmcnt(" #n ")" ::: "memory")
#define PG8_WAIT_L(n) asm volatile("s_waitcnt lgkmcnt(" #n ")" ::: "memory")
#define PG8_BAR __builtin_amdgcn_s_barrier()
#define PG8_SCHED __builtin_amdgcn_sched_barrier(0)
    Unit cur, nxt; int ui = 0;
    if (!S.next(0, cur)) return;
    f32x4 acc[2][2][4][2];
#pragma unroll
    for (int a = 0; a < 2; ++a)
#pragma unroll
        for (int b = 0; b < 2; ++b)
#pragma unroll
            for (int m = 0; m < 4; ++m)
#pragma unroll
                for (int n = 0; n < 2; ++n) acc[a][b][m][n] = (f32x4){0.f, 0.f, 0.f, 0.f};
    bf16x8 At[4][2], B0[2][2], B1[2][2];
    const char* cA = (const char*)g.A + (size_t)cur.pm * tstep; const char* cB = (const char*)g.Bt + (size_t)cur.pn * tstep;
    S.a_ready(cur);
    if constexpr (SP2) {
        PG8_STAGE(PG8_SB(0, 0), cB, voffB); PG8_STAGE(PG8_SB(0, 1), cB + hstep, voffB); PG8_STAGE(PG8_SA(0, 0), cA, voffA); PG8_STAGE(PG8_SA(0, 1), cA + hstep, voffA);
        if (wr == 1) PG8_BAR;
        PG8_WAIT_V(2); PG8_BAR;
        PG8_STAGE(PG8_SB(1, 0), cB + kstep, voffB); PG8_STAGE(PG8_SA(1, 0), cA + kstep, voffA); PG8_STAGE(PG8_SB(1, 1), cB + hstep + kstep, voffB);
        PG8_WAIT_V(6); PG8_BAR;
    } else {
        PG8_STAGE(PG8_SB(0, 0), cB, voffB); PG8_STAGE(PG8_SA(0, 0), cA, voffA); PG8_STAGE(PG8_SB(0, 1), cB + hstep, voffB); PG8_STAGE(PG8_SA(0, 1), cA + hstep, voffA);
        if (wr == 1) PG8_BAR;
        PG8_WAIT_V(4); PG8_BAR;
        PG8_STAGE(PG8_SB(1, 0), cB + kstep, voffB); PG8_STAGE(PG8_SA(1, 0), cA + kstep, voffA); PG8_STAGE(PG8_SB(1, 1), cB + hstep + kstep, voffB);
        PG8_WAIT_V(6); PG8_BAR;
    }
    for (;;) {
        const bool has_next = S.next(ui + 1, nxt);
        const char* nA = has_next ? (const char*)g.A + (size_t)nxt.pm * tstep : cA; const char* nB = has_next ? (const char*)g.Bt + (size_t)nxt.pn * tstep : cB;
        for (int t = 0; t < nt; t += 2) {
            const bool last = (t == nt - 2);
            const char* a1 = cA + (size_t)(t + 1) * kstep;
            const char* a2 = last ? nA : cA + (size_t)(t + 2) * kstep; const char* b2 = last ? nB : cB + (size_t)(t + 2) * kstep;
            const char* a3 = a2 + kstep; const char* b3 = b2 + kstep;
            if (last && has_next) S.a_ready(nxt);
            if constexpr (SP2) {
            PG8_LDB(B0, 0, 0); PG8_LDB(B1, 0, 1); PG8_SCHED; PG8_LDA(At, 0, 0); PG8_STAGE(PG8_SA(1, 1), a1 + hstep, voffA);
            PG8_WAIT_V(8); PG8_WAIT_L(0); PG8_BAR; PG8_MMA(0, 0, At, B0); PG8_MMA(0, 1, At, B1); PG8_BAR; PG8_SCHED;
            PG8_LDA(At, 0, 1); PG8_STAGE(PG8_SB(0, 0), b2, voffB); PG8_STAGE(PG8_SB(0, 1), b2 + hstep, voffB); PG8_STAGE(PG8_SA(0, 0), a2, voffA);
            PG8_WAIT_V(8); PG8_WAIT_L(0); PG8_BAR; PG8_MMA(1, 0, At, B0); PG8_MMA(1, 1, At, B1); PG8_BAR; PG8_SCHED;
            PG8_LDB(B0, 1, 0); PG8_LDB(B1, 1, 1); PG8_SCHED; PG8_LDA(At, 1, 0); PG8_STAGE(PG8_SA(0, 1), a2 + hstep, voffA);
            PG8_WAIT_V(8); PG8_WAIT_L(0); PG8_BAR; PG8_MMA(0, 0, At, B0); PG8_MMA(0, 1, At, B1); PG8_BAR; PG8_SCHED;
            PG8_LDA(At, 1, 1); PG8_STAGE(PG8_SB(1, 0), b3, voffB); PG8_STAGE(PG8_SB(1, 1), b3 + hstep, voffB); PG8_STAGE(PG8_SA(1, 0), a3, voffA);
            PG8_WAIT_V(8); PG8_WAIT_L(0); PG8_BAR; PG8_MMA(1, 0, At, B0); PG8_MMA(1, 1, At, B1); PG8_BAR; PG8_SCHED;
            } else {
            PG8_LDB(B0, 0, 0); PG8_SCHED; PG8_LDA(At, 0, 0); PG8_STAGE(PG8_SA(1, 1), a1 + hstep, voffA);
            PG8_WAIT_L(8); PG8_BAR; PG8_WAIT_L(0); PG8_MMA(0, 0, At, B0); PG8_BAR; PG8_SCHED;
            PG8_LDB(B1, 0, 1); PG8_STAGE(PG8_SB(0, 0), b2, voffB);
            PG8_BAR; PG8_WAIT_L(0); PG8_MMA(0, 1, At, B1); PG8_BAR;
            PG8_LDA(At, 0, 1); PG8_STAGE(PG8_SA(0, 0), a2, voffA);
            PG8_BAR; PG8_WAIT_L(0); PG8_MMA(1, 0, At, B0); PG8_BAR; PG8_SCHED;
            PG8_STAGE(PG8_SB(0, 1), b2 + hstep, voffB);
            PG8_WAIT_V(6); PG8_BAR; PG8_MMA(1, 1, At, B1); PG8_BAR;
            PG8_LDB(B0, 1, 0); PG8_SCHED; PG8_LDA(At, 1, 0); PG8_STAGE(PG8_SA(0, 1), a2 + hstep, voffA);
            PG8_WAIT_L(8); PG8_BAR; PG8_WAIT_L(0); PG8_MMA(0, 0, At, B0); PG8_BAR; PG8_SCHED;
            PG8_LDB(B1, 1, 1); PG8_STAGE(PG8_SB(1, 0), b3, voffB);
            PG8_BAR; PG8_WAIT_L(0); PG8_MMA(0, 1, At, B1); PG8_BAR;
            PG8_LDA(At, 1, 1); PG8_STAGE(PG8_SA(1, 0), a3, voffA);
            PG8_BAR; PG8_WAIT_L(0); PG8_MMA(1, 0, At, B0); PG8_BAR; PG8_SCHED;
            PG8_STAGE(PG8_SB(1, 1), b3 + hstep, voffB);
            PG8_WAIT_V(6); PG8_BAR; PG8_MMA(1, 1, At, B1); PG8_BAR;
            }
        }
        if constexpr (ALIGN_EPI) { if (wr == 0) PG8_BAR; }
        if constexpr (!Epi::AFTER_DRAIN) { E(acc, cur, wr, wc, fr, fq); S.done(cur); }
        if (!has_next) break;
#pragma unroll
        for (int a = 0; a < 2; ++a)
#pragma unroll
            for (int b = 0; b < 2; ++b)
#pragma unroll
                for (int m = 0; m < 4; ++m)
#pragma unroll
                    for (int n = 0; n < 2; ++n) acc[a][b][m][n] = (f32x4){0.f, 0.f, 0.f, 0.f};
        cur = nxt; cA = nA; cB = nB; ++ui;
        if constexpr (ALIGN_EPI) { if (wr == 1) PG8_BAR; }
    }
    PG8_WAIT_V(0);
    if constexpr (!ALIGN_EPI) { if (wr == 0) PG8_BAR; }
    PG8_BAR;
    if constexpr (Epi::AFTER_DRAIN) { E.fused(acc, cur, wr, wc, fr, fq, lds, wid, lane); S.done(cur); }
#undef PG8_SA
#undef PG8_SB
#undef PG8_STAGE
#undef PG8_LDA
#undef PG8_LDB
#undef PG8_MMA
#undef PG8_WAIT_V
#undef PG8_WAIT_L
#undef PG8_BAR
#undef PG8_SCHED
}
}

#define LAS __attribute__((address_space(3)))
typedef unsigned short bf16;
typedef short bf16x8 __attribute__((ext_vector_type(8)));
typedef float f32x4 __attribute__((ext_vector_type(4)));
typedef unsigned u32x4 __attribute__((ext_vector_type(4)));
typedef unsigned u32x2 __attribute__((ext_vector_type(2)));
constexpr int NWAVES = 8, NTHR = 512;
constexpr int SEQ = 4096, D = 2048, M = 8192, HD = 128, FF = 5632, NIN = 8192, NSC = 6144, NUP = 11264;
constexpr int NTASK = 2048;
constexpr float EPS = 1e-6f;
constexpr int LDS_BYTES = 147456;

constexpr size_t MiB = 1u << 20;
constexpr size_t WS_WIN = 1 * MiB, WS_WOH = WS_WIN + 32 * MiB, WS_WUP0 = WS_WOH + 8 * MiB, WS_WUP1 = WS_WUP0 + 44 * MiB, WS_WDN0 = WS_WUP1 + 44 * MiB, WS_WDN1 = WS_WDN0 + 22 * MiB,
                 WS_WSI = WS_WDN1 + 22 * MiB, WS_WSO = WS_WSI + 24 * MiB, WS_XN = WS_WSO + 8 * MiB, WS_R = WS_XN + 32 * MiB;
constexpr size_t WS_Q = WS_R, WS_LOGF = WS_Q + 32 * MiB  , WS_V = WS_LOGF + 64 * MiB  , WS_G = WS_V + 32 * MiB, WS_UT = WS_G + 32 * MiB, WS_SP = WS_UT + 128 * MiB,
                 WS_DEC = WS_SP + 64 * MiB, WS_SS = WS_DEC + 1 * MiB, WS_R_END = WS_SS + 1 * MiB;
constexpr size_t WS_U = WS_R, WS_ACT = WS_U + 176 * MiB;
constexpr size_t WS_P2 = WS_R, WS_Y = WS_P2 + 96 * MiB;
constexpr size_t WS_END = WS_R_END;
static_assert(WS_ACT + 88 * MiB <= WS_END && WS_Y + 32 * MiB <= WS_END, "ws map");

__device__ __forceinline__ unsigned pk_bf16(float lo, float hi) { return pg8::cvt_pk_bf16(lo, hi); }
__device__ __forceinline__ float bf_lo(unsigned w) { return __uint_as_float(w << 16); }
__device__ __forceinline__ float bf_hi(unsigned w) { return __uint_as_float(w & 0xffff0000u); }
__device__ __forceinline__ float bf1(bf16 h) { return __uint_as_float(((unsigned)h) << 16); }
__device__ __forceinline__ float wave_sum(float v) {
#pragma unroll
    for (int o = 1; o < 64; o <<= 1) v += __shfl_xor(v, o);
    return v;
}
__device__ __forceinline__ int lane_id() { int l; asm volatile("v_mbcnt_lo_u32_b32 %0, -1, 0\n\tv_mbcnt_hi_u32_b32 %0, -1, %0" : "=v"(l)); return l; }
__device__ __forceinline__ float silu_f(float a) { return a * __builtin_amdgcn_rcpf(1.0f + __expf(-a)); }

__device__ __forceinline__ void p0_transpose_item(const float* W, int K, int N, bf16* WT, LAS float* scr, int item, int lane) {
    const int nblk = N / 32, kb = item / nblk, nb = item % nblk, k0 = 64 * kb, n0 = 32 * nb;
#pragma unroll 8
    for (int i = 0; i < 32; ++i) { const int kk = 2 * i + (lane >> 5); scr[kk * 33 + (lane & 31)] = W[(size_t)(k0 + kk) * N + n0 + (lane & 31)]; }
    asm volatile("s_waitcnt lgkmcnt(0)" ::: "memory");
    const int c = lane & 7;
#pragma unroll
    for (int j = 0; j < 4; ++j) { const int n = (lane >> 3) + 8 * j; const LAS float* s = scr + (8 * c) * 33 + n;
        u32x4 o; o.x = pk_bf16(s[0 * 33], s[1 * 33]); o.y = pk_bf16(s[2 * 33], s[3 * 33]); o.z = pk_bf16(s[4 * 33], s[5 * 33]); o.w = pk_bf16(s[6 * 33], s[7 * 33]);
        *(u32x4*)(WT + (size_t)(n0 + n) * K + k0 + 8 * c) = o; }
    asm volatile("s_waitcnt lgkmcnt(0)" ::: "memory");
}

__device__ __forceinline__ void rms_row_bf16(const float* xrow, const float* w, bf16* orow, int lane) {
    const f32x4* xr = (const f32x4*)xrow + lane; const f32x4* wr = (const f32x4*)w + lane;
    f32x4 v[8]; float s = 0.f;
#pragma unroll
    for (int j = 0; j < 8; ++j) { v[j] = xr[64 * j]; s += (v[j][0] * v[j][0] + v[j][1] * v[j][1]) + (v[j][2] * v[j][2] + v[j][3] * v[j][3]); }
    const float rstd = __builtin_amdgcn_rsqf(wave_sum(s) * (1.0f / D) + EPS);
    u32x2* o8 = (u32x2*)orow + lane;
#pragma unroll
    for (int j = 0; j < 8; ++j) { const f32x4 g = wr[64 * j]; u32x2 o; o.x = pk_bf16(v[j][0] * rstd * g[0], v[j][1] * rstd * g[1]); o.y = pk_bf16(v[j][2] * rstd * g[2], v[j][3] * rstd * g[3]); o8[64 * j] = o; }
}
__device__ __forceinline__ void rms_row_f32(const float* xrow, const float* w, float* orow, int lane) {
    const f32x4* xr = (const f32x4*)xrow + lane; const f32x4* wr = (const f32x4*)w + lane;
    f32x4 v[8]; float s = 0.f;
#pragma unroll
    for (int j = 0; j < 8; ++j) { v[j] = xr[64 * j]; s += (v[j][0] * v[j][0] + v[j][1] * v[j][1]) + (v[j][2] * v[j][2] + v[j][3] * v[j][3]); }
    const float rstd = __builtin_amdgcn_rsqf(wave_sum(s) * (1.0f / D) + EPS);
    f32x4* o = (f32x4*)orow + lane;
#pragma unroll
    for (int j = 0; j < 8; ++j) { const f32x4 g = wr[64 * j]; o[64 * j] = v[j] * rstd * g; }
}

__device__ __forceinline__ void unpack8(const u32x4 w, float (&f)[8]) { f[0] = bf_lo(w.x); f[1] = bf_hi(w.x); f[2] = bf_lo(w.y); f[3] = bf_hi(w.y); f[4] = bf_lo(w.z); f[5] = bf_hi(w.z); f[6] = bf_lo(w.w); f[7] = bf_hi(w.w); }
__device__ __forceinline__ void load8f(const float* p, float (&f)[8]) { const f32x4 a = *(const f32x4*)p, b = *(const f32x4*)(p + 4); f[0] = a[0]; f[1] = a[1]; f[2] = a[2]; f[3] = a[3]; f[4] = b[0]; f[5] = b[1]; f[6] = b[2]; f[7] = b[3]; }
__device__ __forceinline__ void conv_glu_phase(const bf16* U, const float* cw  , bf16* ACT, int gtid, int gthreads) {
    constexpr int NCG = FF / 8, RS = 16, NSEG = M / RS;
    for (int it = gtid; it < NCG * NSEG; it += gthreads) {
        const int jg = it % NCG, seg = it / NCG, c0 = jg * 8, t0 = seg * RS;
        float wg[3][8], wv[3][8];
#pragma unroll
        for (int k = 0; k < 3; ++k) { load8f(cw + k * NUP + c0, wg[k]); load8f(cw + k * NUP + FF + c0, wv[k]); }
        float g2[8], g1[8], v2[8], v1[8];
        if ((t0 & (SEQ - 1)) == 0) {
#pragma unroll
            for (int j = 0; j < 8; ++j) { g2[j] = 0.f; g1[j] = 0.f; v2[j] = 0.f; v1[j] = 0.f; }
        } else {
            unpack8(*(const u32x4*)(U + (size_t)(t0 - 2) * NUP + c0), g2); unpack8(*(const u32x4*)(U + (size_t)(t0 - 1) * NUP + c0), g1);
            unpack8(*(const u32x4*)(U + (size_t)(t0 - 2) * NUP + FF + c0), v2); unpack8(*(const u32x4*)(U + (size_t)(t0 - 1) * NUP + FF + c0), v1);
        }
#pragma unroll 4
        for (int r = 0; r < RS; ++r) {
            float g0[8], v0[8];
            unpack8(*(const u32x4*)(U + (size_t)(t0 + r) * NUP + c0), g0); unpack8(*(const u32x4*)(U + (size_t)(t0 + r) * NUP + FF + c0), v0);
            float o[8];
#pragma unroll
            for (int j = 0; j < 8; ++j) { const float cgv = wg[0][j] * g2[j] + wg[1][j] * g1[j] + wg[2][j] * g0[j]; const float cvv = wv[0][j] * v2[j] + wv[1][j] * v1[j] + wv[2][j] * v0[j];
                o[j] = silu_f(cgv) * cvv; g2[j] = g1[j]; g1[j] = g0[j]; v2[j] = v1[j]; v1[j] = v0[j]; }
            u32x4 w; w.x = pk_bf16(o[0], o[1]); w.y = pk_bf16(o[2], o[3]); w.z = pk_bf16(o[4], o[5]); w.w = pk_bf16(o[6], o[7]);
            *(u32x4*)(ACT + (size_t)(t0 + r) * FF + c0) = w;
        }
    }
}
__device__ __forceinline__ void short_conv_phase(const bf16* P2, const float* cw  , bf16* Y, int gtid, int gthreads) {
    constexpr int NCG = D / 8, RS = 16, NSEG = M / RS;
    for (int it = gtid; it < NCG * NSEG; it += gthreads) {
        const int jg = it % NCG, seg = it / NCG, c0 = jg * 8, t0 = seg * RS;
        float w3[3][8];
#pragma unroll
        for (int k = 0; k < 3; ++k) load8f(cw + k * D + c0, w3[k]);
        float z2[8], z1[8];
        if ((t0 & (SEQ - 1)) == 0) {
#pragma unroll
            for (int j = 0; j < 8; ++j) { z2[j] = 0.f; z1[j] = 0.f; }
        } else {
            float a[8], b[8];
            unpack8(*(const u32x4*)(P2 + (size_t)(t0 - 2) * NSC + D + c0), a); unpack8(*(const u32x4*)(P2 + (size_t)(t0 - 2) * NSC + 2 * D + c0), b);
#pragma unroll
            for (int j = 0; j < 8; ++j) z2[j] = a[j] * b[j];
            unpack8(*(const u32x4*)(P2 + (size_t)(t0 - 1) * NSC + D + c0), a); unpack8(*(const u32x4*)(P2 + (size_t)(t0 - 1) * NSC + 2 * D + c0), b);
#pragma unroll
            for (int j = 0; j < 8; ++j) z1[j] = a[j] * b[j];
        }
#pragma unroll 4
        for (int r = 0; r < RS; ++r) {
            float gb[8], a[8], b[8], o[8];
            const bf16* rp = P2 + (size_t)(t0 + r) * NSC + c0;
            unpack8(*(const u32x4*)rp, gb); unpack8(*(const u32x4*)(rp + D), a); unpack8(*(const u32x4*)(rp + 2 * D), b);
#pragma unroll
            for (int j = 0; j < 8; ++j) { const float z0 = a[j] * b[j]; o[j] = gb[j] * (w3[0][j] * z2[j] + w3[1][j] * z1[j] + w3[2][j] * z0); z2[j] = z1[j]; z1[j] = z0; }
            u32x4 w; w.x = pk_bf16(o[0], o[1]); w.y = pk_bf16(o[2], o[3]); w.z = pk_bf16(o[4], o[5]); w.w = pk_bf16(o[6], o[7]);
            *(u32x4*)(Y + (size_t)(t0 + r) * D + c0) = w;
        }
    }
}

__device__ __forceinline__ f32x4 mma_t(const bf16x8 a, const bf16x8 b, const f32x4 c) { return __builtin_amdgcn_mfma_f32_16x16x32_bf16(b, a, c, 0, 0, 0); }
constexpr int QE_LD = 136, KT_LD = 72;
constexpr int R1_QE = 0, R1_KE = R1_QE + 64 * QE_LD * 2, R1_KDT = R1_KE + 64 * QE_LD * 2, R1_VT = R1_KDT + 128 * KT_LD * 2, R1_AM = R1_VT + 128 * KT_LD * 2, R1_TOT = R1_AM + 64 * KT_LD * 2, R1_END = R1_TOT + 4 * 128 * 4;
static_assert(R1_END <= 131072, "R1 LDS");

__device__ __forceinline__ void r1_phase(unsigned char* lds, bf16* Q, const float* LOGF, const bf16* V, float* OINTRA, float* UT, float* DEC, int nblk, int blk, const int wid, const int lane) {
    const int tid = wid * 64 + lane, fr = lane & 15, fq = lane >> 4;
    bf16* sQE = (bf16*)(lds + R1_QE); bf16* sKE = (bf16*)(lds + R1_KE); bf16* sKDT = (bf16*)(lds + R1_KDT); bf16* sVT = (bf16*)(lds + R1_VT); bf16* sAM = (bf16*)(lds + R1_AM); float* sTOT = (float*)(lds + R1_TOT);
    const int seg = tid >> 7, d = tid & 127;
    for (int task = blk; task < NTASK; task += nblk) {
        const int bh = task >> 6, c = task & 63, b_ = bh >> 4, h = bh & 15, m0 = b_ * SEQ + c * 64;
        const size_t gbase = (size_t)(m0 + seg * 16) * D + h * HD + d;
        float lf[16], cs[16];
#pragma unroll
        for (int i = 0; i < 16; ++i) lf[i] = LOGF[gbase + (size_t)i * D];
        float run = 0.f;
#pragma unroll
        for (int i = 0; i < 16; ++i) { run += lf[i]; cs[i] = run; }
        sTOT[seg * 128 + d] = run;
        __syncthreads();
        const float t0 = sTOT[d], t1 = sTOT[128 + d], t2 = sTOT[256 + d], t3 = sTOT[384 + d];
        const float off = (seg > 0 ? t0 : 0.f) + (seg > 1 ? t1 : 0.f) + (seg > 2 ? t2 : 0.f);
        const float rref = t0 + t1, blast = (t0 + t1) + (t2 + t3);
        unsigned kdp[8], vtp[8];
#pragma unroll
        for (int i = 0; i < 16; i += 2) {
            float kd2[2]; unsigned short vraw[2];
#pragma unroll
            for (int e = 0; e < 2; ++e) { const int ii = i + e; const float bb = cs[ii] + off; const float qv = bf1(Q[gbase + (size_t)ii * D]); const float kk = 1.0f - __expf(lf[ii]);
                const float qe = qv * __expf(bb - rref), ke = kk * __expf(rref - bb); kd2[e] = kk * __expf(blast - bb);
                const int t = seg * 16 + ii;
                sQE[t * QE_LD + d] = (bf16)(pk_bf16(qe, 0.f) & 0xffffu); sKE[t * QE_LD + d] = (bf16)(pk_bf16(ke, 0.f) & 0xffffu);
                Q[gbase + (size_t)ii * D] = (bf16)(pk_bf16(qv * __expf(bb), 0.f) & 0xffffu);
                vraw[e] = V[gbase + (size_t)ii * D]; }
            kdp[i >> 1] = pk_bf16(kd2[0], kd2[1]); vtp[i >> 1] = (unsigned)vraw[0] | ((unsigned)vraw[1] << 16);
        }
        { u32x4 w0, w1; w0.x = kdp[0]; w0.y = kdp[1]; w0.z = kdp[2]; w0.w = kdp[3]; w1.x = kdp[4]; w1.y = kdp[5]; w1.z = kdp[6]; w1.w = kdp[7];
          *(u32x4*)(sKDT + d * KT_LD + seg * 16) = w0; *(u32x4*)(sKDT + d * KT_LD + seg * 16 + 8) = w1;
          w0.x = vtp[0]; w0.y = vtp[1]; w0.z = vtp[2]; w0.w = vtp[3]; w1.x = vtp[4]; w1.y = vtp[5]; w1.z = vtp[6]; w1.w = vtp[7];
          *(u32x4*)(sVT + d * KT_LD + seg * 16) = w0; *(u32x4*)(sVT + d * KT_LD + seg * 16 + 8) = w1; }
        if (seg == 0) DEC[(size_t)task * 128 + d] = __expf(blast);
        __syncthreads();
#pragma unroll
        for (int q = 0; q < 2; ++q) { const int id = wid * 2 + q, ti = id >> 2, sj = id & 3; f32x4 acc = {0.f, 0.f, 0.f, 0.f};
            if (sj <= ti) {
#pragma unroll
                for (int kk = 0; kk < 4; ++kk) { const bf16x8 a = *(const bf16x8*)(sQE + (ti * 16 + fr) * QE_LD + kk * 32 + fq * 8), b = *(const bf16x8*)(sKE + (sj * 16 + fr) * QE_LD + kk * 32 + fq * 8); acc = mma_t(a, b, acc); }
                const int t = ti * 16 + fr, s0 = sj * 16 + 4 * fq;
#pragma unroll
                for (int j = 0; j < 4; ++j) if (s0 + j > t) acc[j] = 0.f;
            }
            u32x2 w; w.x = pk_bf16(acc[0], acc[1]); w.y = pk_bf16(acc[2], acc[3]);
            *(u32x2*)(sAM + (ti * 16 + fr) * KT_LD + sj * 16 + 4 * fq) = w; }
        { const bf16x8 a0 = *(const bf16x8*)(sVT + (wid * 16 + fr) * KT_LD + fq * 8), a1 = *(const bf16x8*)(sVT + (wid * 16 + fr) * KT_LD + 32 + fq * 8);
          float* up = UT + (size_t)task * 16384 + (size_t)(wid * 16 + fr) * 128 + 4 * fq;
#pragma unroll
          for (int dj = 0; dj < 8; ++dj) { const bf16x8 b0 = *(const bf16x8*)(sKDT + (dj * 16 + fr) * KT_LD + fq * 8), b1 = *(const bf16x8*)(sKDT + (dj * 16 + fr) * KT_LD + 32 + fq * 8);
              f32x4 acc = {0.f, 0.f, 0.f, 0.f}; acc = mma_t(a0, b0, acc); acc = mma_t(a1, b1, acc); *(f32x4*)(up + dj * 16) = acc; } }
        __syncthreads();
        { const int ti = wid >> 1; const bf16x8 a0 = *(const bf16x8*)(sAM + (ti * 16 + fr) * KT_LD + fq * 8), a1 = *(const bf16x8*)(sAM + (ti * 16 + fr) * KT_LD + 32 + fq * 8);
          float* op = OINTRA + (size_t)(m0 + ti * 16 + fr) * D + h * HD + 4 * fq;
#pragma unroll
          for (int q = 0; q < 4; ++q) { const int vj = (wid & 1) * 4 + q; const bf16x8 b0 = *(const bf16x8*)(sVT + (vj * 16 + fr) * KT_LD + fq * 8), b1 = *(const bf16x8*)(sVT + (vj * 16 + fr) * KT_LD + 32 + fq * 8);
              f32x4 acc = {0.f, 0.f, 0.f, 0.f}; acc = mma_t(a0, b0, acc); acc = mma_t(a1, b1, acc); *(f32x4*)(op + vj * 16) = acc; } }
        __syncthreads();
    }
}
__device__ __forceinline__ void r2_phase(const float* UT, const float* DEC, bf16* SP, int gtid, int gthreads) {
    for (int e = gtid; e < 32 * 4096; e += gthreads) {
        const int bh = e >> 12, rem = e & 4095, d4 = (rem & 31) * 4;
        f32x4 S = {0.f, 0.f, 0.f, 0.f};
#pragma unroll 8
        for (int c = 0; c < 64; ++c) { const size_t task = (size_t)bh * 64 + c;
            u32x2 w; w.x = pk_bf16(S[0], S[1]); w.y = pk_bf16(S[2], S[3]); *(u32x2*)(SP + task * 16384 + (size_t)rem * 4) = w;
            const f32x4 u = *(const f32x4*)(UT + task * 16384 + (size_t)rem * 4), dc = *(const f32x4*)(DEC + task * 128 + d4);
            S = dc * S + u; }
    }
}
__device__ __forceinline__ void r3_phase(const bf16* QE2, const bf16* SP, const float* OINTRA, const bf16* G, const float* gain, bf16* OG, float* SS, int gw, int ngw, int lane) {
    const int fr = lane & 15, fq = lane >> 4;
    for (int un = gw; un < NTASK * 4; un += ngw) {
        const int task = un >> 2, ti = un & 3, bh = task >> 6, c = task & 63, b_ = bh >> 4, h = bh & 15, row = b_ * SEQ + c * 64 + ti * 16 + fr;
        const bf16* ap = QE2 + (size_t)row * D + h * HD + fq * 8; bf16x8 a[4];
#pragma unroll
        for (int kk = 0; kk < 4; ++kk) a[kk] = *(const bf16x8*)(ap + kk * 32);
        const bf16* sp = SP + (size_t)task * 16384 + (size_t)fr * 128 + fq * 8; const size_t obase = (size_t)row * D + h * HD + 4 * fq;
        float ssum = 0.f;
#pragma unroll
        for (int vj = 0; vj < 8; ++vj) { f32x4 acc = *(const f32x4*)(OINTRA + obase + vj * 16);
#pragma unroll
            for (int kk = 0; kk < 4; ++kk) { const bf16x8 b = *(const bf16x8*)(sp + (size_t)vj * 16 * 128 + kk * 32); acc = mma_t(a[kk], b, acc); }
            ssum += (acc[0] * acc[0] + acc[1] * acc[1]) + (acc[2] * acc[2] + acc[3] * acc[3]);
            const f32x4 gn = *(const f32x4*)(gain + h * HD + vj * 16 + 4 * fq); const u32x2 gw2 = *(const u32x2*)(G + obase + vj * 16);
            u32x2 w; w.x = pk_bf16(acc[0] * gn[0] * bf_lo(gw2.x), acc[1] * gn[1] * bf_hi(gw2.x)); w.y = pk_bf16(acc[2] * gn[2] * bf_lo(gw2.y), acc[3] * gn[3] * bf_hi(gw2.y));
            *(u32x2*)(OG + obase + vj * 16) = w; }
        ssum += __shfl_xor(ssum, 16); ssum += __shfl_xor(ssum, 32);
        if (fq == 0) SS[(size_t)row * 16 + h] = ssum;
    }
}

#define XB_TMO      128
#define XB_XCNT(j)  (256  + 64 * (j))
#define XB_XSUB(j)  (1280 + 64 * (j))
#define XB_XGEN(j)  (2304 + 64 * (j))
#define XB_TOP      3328
#define XB_TOPGEN   3392
#define XCD_BAR_WORDS 3456
#define XB_SPIN_CAP (1u << 20)
__device__ __forceinline__ unsigned xb_ld(unsigned* p)              { return __hip_atomic_load(p, __ATOMIC_RELAXED, __HIP_MEMORY_SCOPE_AGENT); }
__device__ __forceinline__ unsigned xb_add(unsigned* p, unsigned v) { return __hip_atomic_fetch_add(p, v, __ATOMIC_RELAXED, __HIP_MEMORY_SCOPE_AGENT); }
__device__ __forceinline__ unsigned xb_xcc_id() { return (unsigned)__builtin_amdgcn_s_getreg((3 << 11) | 20) & 0xFu; }
#define XB_SPIN(cond, bar) do { unsigned _sp = 0; while (cond) { __builtin_amdgcn_s_sleep(1); \
    if ((++_sp & 255u) == 0u) { if (xb_ld(&(bar)[XB_TMO])) break; if (_sp > XB_SPIN_CAP) { atomicAdd(&(bar)[XB_TMO], 1u); break; } } } } while (0)
__device__ __forceinline__ void xcd_barrier_complete(unsigned* bar, unsigned x, unsigned G, unsigned& nloc, unsigned& nx) {
    unsigned sum, cnt, mine, sp = 0u;
    for (;;) {
        sum = 0u; cnt = 0u; mine = 0u;
#pragma unroll
        for (unsigned j = 0; j < 16; ++j) { const unsigned c = xb_ld(&bar[XB_XCNT(j)]); sum += c; cnt += (c > 0u) ? 1u : 0u; mine = (j == x) ? c : mine; }
        if (sum == G) break;
        __builtin_amdgcn_s_sleep(1);
        if ((++sp & 255u) == 0u) { if (xb_ld(&bar[XB_TMO])) break; if (sp > XB_SPIN_CAP) { atomicAdd(&bar[XB_TMO], 1u); break; } }
    }
    nloc = mine > 0u ? mine : 1u; nx = cnt > 0u ? cnt : 1u;
}
__device__ __forceinline__ void xcd_barrier(unsigned* bar, volatile LAS unsigned* st, int wave, unsigned G) {
    asm volatile("s_waitcnt vmcnt(0)" ::: "memory");
    __syncthreads();
    if (wave == 0 && lane_id() == 0) {
        const unsigned x = xb_xcc_id();
        __builtin_amdgcn_s_waitcnt(0);
        unsigned nloc = st[0], nx = st[1];
        if (nloc == 0u) { xcd_barrier_complete(bar, x, G, nloc, nx); st[0] = nloc; st[1] = nx; }
        const unsigned old = xb_add(&bar[XB_XSUB(x)], 1u);
        const unsigned gen = old / nloc;
        if (old + 1u == (gen + 1u) * nloc) {
            __builtin_amdgcn_fence(__ATOMIC_RELEASE, "agent");
            asm volatile("s_waitcnt vmcnt(0)" ::: "memory");
            const unsigned og = xb_add(&bar[XB_TOP], 1u);
            const unsigned tg = og / nx;
            if (og + 1u == (tg + 1u) * nx) xb_add(&bar[XB_TOPGEN], 1u);
            else XB_SPIN(xb_ld(&bar[XB_TOPGEN]) == tg, bar);
            __builtin_amdgcn_fence(__ATOMIC_ACQUIRE, "agent");
            xb_add(&bar[XB_XGEN(x)], 1u);
            asm volatile("s_waitcnt vmcnt(0)" ::: "memory");
        } else {
            XB_SPIN(xb_ld(&bar[XB_XGEN(x)]) == gen, bar);
            __builtin_amdgcn_fence(__ATOMIC_ACQUIRE, "agent");
            asm volatile("s_waitcnt vmcnt(0)" ::: "memory");
        }
    }
    __syncthreads();
}

enum { PH_P0 = 0, PH_G1, PH_R1, PH_R2, PH_R3, PH_G2, PH_N1, PH_G3, PH_C1, PH_G4, PH_N2, PH_G5, PH_C2, PH_G6, PH_N3, PH_G7, PH_C3, PH_G8, PH_FN, NPH };
struct Args { const float* in[14]; float* out; unsigned char* ws; int ph_lo, ph_hi; };

__global__ void __launch_bounds__(NTHR, 2) trunk_fwd(Args args) {
    extern __shared__ __attribute__((aligned(16))) unsigned char lds[];
    const int wave = __builtin_amdgcn_readfirstlane(threadIdx.x >> 6);
    const int G_ = gridDim.x, blk = blockIdx.x, ngw = G_ * NWAVES, gthreads = G_ * NTHR;
#define LANE_SETUP() int lane = lane_id(); asm volatile("" : "+v"(lane)); const int tid = wave * 64 + lane, gw = blk * NWAVES + wave, gtid = blk * NTHR + tid; (void)tid; (void)gw; (void)gtid
    unsigned char* ws = args.ws;
    float* H = args.out;
    bf16* XN = (bf16*)(ws + WS_XN);
    const int lo = args.ph_lo, hi = args.ph_hi;
#define IN(k) (lo <= (k) && (k) < hi)
    if (lo < 0) cg::this_grid().sync();
    volatile LAS unsigned* bst = (volatile LAS unsigned*)((LAS unsigned char*)lds + 131072 + 1024);
    unsigned* bar = (unsigned*)ws;
    if (hi - lo > 1) {
        if (wave == 0) { const int l0 = lane_id(); if (l0 < 2) bst[l0] = 0u; if (l0 == 0) (void)xb_add(&bar[XB_XCNT(xb_xcc_id())], 1u); }
        __syncthreads();
    }
#define SEAM(k) do { if ((k) + 1 < hi) xcd_barrier(bar, bst, wave, (unsigned)G_); } while (0)
#define RUN_GEMM(MODE, KC, Aptr, Bptr, NN, SETUP) do { pg8::Gemm g{(const bf16*)(Aptr), (const bf16*)(Bptr), M, (NN), (KC)}; pg8::Epi<MODE, KC> E{}; SETUP; \
        pg8::StaticOrder S; S.init(M, (NN), G_, blk); pg8::gemm_phase<pg8::Epi<MODE, KC>, pg8::StaticOrder, true, true>((LAS unsigned char*)lds, g, S, E, wave); } while (0)
    if (IN(PH_P0)) { LANE_SETUP();
        LAS float* scr = (LAS float*)((LAS unsigned char*)lds + wave * 16384);
        constexpr int I_IN = (D / 64) * (NIN / 32), I_OH = (D / 64) * (D / 32), I_UP = (D / 64) * (NUP / 32), I_DN = (FF / 64) * (D / 32), I_SI = (D / 64) * (NSC / 32), I_SO = I_OH;
        constexpr int NITEMS = I_IN + I_OH + 2 * I_UP + 2 * I_DN + I_SI + I_SO;
        for (int it = gw; it < NITEMS; it += ngw) {
            int r = it;
            if (r < I_IN) { p0_transpose_item(args.in[3], D, NIN, (bf16*)(ws + WS_WIN), scr, r, lane); continue; } r -= I_IN;
            if (r < I_OH) { p0_transpose_item(args.in[6], D, D, (bf16*)(ws + WS_WOH), scr, r, lane); continue; } r -= I_OH;
            if (r < I_UP) { p0_transpose_item(args.in[10], D, NUP, (bf16*)(ws + WS_WUP0), scr, r, lane); continue; } r -= I_UP;
            if (r < I_DN) { p0_transpose_item(args.in[12], FF, D, (bf16*)(ws + WS_WDN0), scr, r, lane); continue; } r -= I_DN;
            if (r < I_SI) { p0_transpose_item(args.in[7], D, NSC, (bf16*)(ws + WS_WSI), scr, r, lane); continue; } r -= I_SI;
            if (r < I_SO) { p0_transpose_item(args.in[9], D, D, (bf16*)(ws + WS_WSO), scr, r, lane); continue; } r -= I_SO;
            if (r < I_UP) { p0_transpose_item(args.in[10] + (size_t)D * NUP, D, NUP, (bf16*)(ws + WS_WUP1), scr, r, lane); continue; } r -= I_UP;
            p0_transpose_item(args.in[12] + (size_t)FF * D, FF, D, (bf16*)(ws + WS_WDN1), scr, r, lane);
        }
        for (int m = gw; m < M; m += ngw) rms_row_bf16(args.in[0] + (size_t)m * D, args.in[1], XN + (size_t)m * D, lane);
        SEAM(PH_P0);
    }
    if (IN(PH_G1)) {
        RUN_GEMM(2, 2048, XN, ws + WS_WIN, NIN, (E.Q = (bf16*)(ws + WS_Q), E.LOGF = (float*)(ws + WS_LOGF), E.V = (bf16*)(ws + WS_V), E.G = (bf16*)(ws + WS_G), E.lbt = args.in[4]));
        SEAM(PH_G1);
    }
    if (IN(PH_R1)) { LANE_SETUP();
#ifndef NO_R1
        r1_phase(lds, (bf16*)(ws + WS_Q), (const float*)(ws + WS_LOGF), (const bf16*)(ws + WS_V), (float*)(ws + WS_LOGF), (float*)(ws + WS_UT), (float*)(ws + WS_DEC), G_, blk, wave, lane);
#endif
        SEAM(PH_R1);
    }
    if (IN(PH_R2)) { LANE_SETUP();
#ifndef NO_R2
        r2_phase((const float*)(ws + WS_UT), (const float*)(ws + WS_DEC), (bf16*)(ws + WS_SP), gtid, gthreads);
#endif
        SEAM(PH_R2);
    }
    if (IN(PH_R3)) { LANE_SETUP();
#ifndef NO_R3
        r3_phase((const bf16*)(ws + WS_Q), (const bf16*)(ws + WS_SP), (const float*)(ws + WS_LOGF), (const bf16*)(ws + WS_G), args.in[5], (bf16*)(ws + WS_V), (float*)(ws + WS_SS), gw, ngw, lane);
#endif
        SEAM(PH_R3);
    }
    if (IN(PH_G2)) {
        RUN_GEMM(1, 2048, ws + WS_V, ws + WS_WOH, D, (E.out = H, E.res = args.in[0], E.ss = (const float*)(ws + WS_SS)));
        SEAM(PH_G2);
    }
    if (IN(PH_N1)) { LANE_SETUP(); for (int m = gw; m < M; m += ngw) rms_row_bf16(H + (size_t)m * D, args.in[2], XN + (size_t)m * D, lane); SEAM(PH_N1); }
    if (IN(PH_G3)) { RUN_GEMM(0, 2048, XN, ws + WS_WUP0, NUP, (E.O = (bf16*)(ws + WS_U), E.ldc = NUP)); SEAM(PH_G3); }
    if (IN(PH_C1)) { LANE_SETUP();
#ifndef NO_CONV
        conv_glu_phase((const bf16*)(ws + WS_U), args.in[11], (bf16*)(ws + WS_ACT), gtid, gthreads);
#endif
        SEAM(PH_C1);
    }
    if (IN(PH_G4)) { RUN_GEMM(1, 5632, ws + WS_ACT, ws + WS_WDN0, D, (E.out = H, E.res = H, E.ss = nullptr)); SEAM(PH_G4); }
    if (IN(PH_N2)) { LANE_SETUP(); for (int m = gw; m < M; m += ngw) rms_row_bf16(H + (size_t)m * D, args.in[1] + D, XN + (size_t)m * D, lane); SEAM(PH_N2); }
    if (IN(PH_G5)) { RUN_GEMM(0, 2048, XN, ws + WS_WSI, NSC, (E.O = (bf16*)(ws + WS_P2), E.ldc = NSC)); SEAM(PH_G5); }
    if (IN(PH_C2)) { LANE_SETUP();
#ifndef NO_CONV
        short_conv_phase((const bf16*)(ws + WS_P2), args.in[8], (bf16*)(ws + WS_Y), gtid, gthreads);
#endif
        SEAM(PH_C2);
    }
    if (IN(PH_G6)) { RUN_GEMM(1, 2048, ws + WS_Y, ws + WS_WSO, D, (E.out = H, E.res = H, E.ss = nullptr)); SEAM(PH_G6); }
    if (IN(PH_N3)) { LANE_SETUP(); for (int m = gw; m < M; m += ngw) rms_row_bf16(H + (size_t)m * D, args.in[2] + D, XN + (size_t)m * D, lane); SEAM(PH_N3); }
    if (IN(PH_G7)) { RUN_GEMM(0, 2048, XN, ws + WS_WUP1, NUP, (E.O = (bf16*)(ws + WS_U), E.ldc = NUP)); SEAM(PH_G7); }
    if (IN(PH_C3)) { LANE_SETUP();
#ifndef NO_CONV
        conv_glu_phase((const bf16*)(ws + WS_U), args.in[11] + 3 * NUP, (bf16*)(ws + WS_ACT), gtid, gthreads);
#endif
        SEAM(PH_C3);
    }
    if (IN(PH_G8)) { RUN_GEMM(1, 5632, ws + WS_ACT, ws + WS_WDN1, D, (E.out = H, E.res = H, E.ss = nullptr)); SEAM(PH_G8); }
    if (IN(PH_FN)) { LANE_SETUP(); for (int m = gw; m < M; m += ngw) rms_row_f32(H + (size_t)m * D, args.in[13], H + (size_t)m * D, lane); }
#undef IN
#undef LANE_SETUP
#undef SEAM
#undef RUN_GEMM
}

extern "C" void kernel_launch(void* const* d_in, const int* in_sizes, int n_in, void* d_out, int out_size, void* d_ws, size_t ws_size, hipStream_t stream) {
    static int grid = 0;
    if (grid == 0) {
        if (n_in != 14 || in_sizes[0] != M * D || out_size != M * D || ws_size < WS_END) { fprintf(stderr, "kernel_launch: unexpected shapes (n_in %d, in0 %d, out %d, ws %zu < %zu)\n", n_in, n_in > 0 ? in_sizes[0] : -1, out_size, ws_size, (size_t)WS_END); grid = -1; return; }
        int dev = 0, cus = 0, per_cu = 0;
        if (hipGetDevice(&dev) != hipSuccess || hipDeviceGetAttribute(&cus, hipDeviceAttributeMultiprocessorCount, dev) != hipSuccess) { grid = -1; return; }
        if (hipFuncSetAttribute((const void*)trunk_fwd, hipFuncAttributeMaxDynamicSharedMemorySize, LDS_BYTES) != hipSuccess) { fprintf(stderr, "kernel_launch: hipFuncSetAttribute failed\n"); grid = -1; return; }
        if (hipOccupancyMaxActiveBlocksPerMultiprocessor(&per_cu, (const void*)trunk_fwd, NTHR, LDS_BYTES) != hipSuccess || per_cu < 1) { fprintf(stderr, "kernel_launch: occupancy query says %d\n", per_cu); per_cu = 1; }
        (void)hipGetLastError();
        grid = cus * 1;
    }
    if (grid < 0) return;
    if (hipMemsetAsync(d_ws, 0, 16384, stream) != hipSuccess) { fprintf(stderr, "kernel_launch: memset failed\n"); return; }
    Args a{};
    for (int i = 0; i < 14; ++i) a.in[i] = (const float*)d_in[i];
    a.out = (float*)d_out; a.ws = (unsigned char*)d_ws;
#if MK_SINGLE
    a.ph_lo = 0; a.ph_hi = NPH;
    void* kargs[] = {&a};
    hipError_t e = hipLaunchCooperativeKernel((const void*)trunk_fwd, dim3(grid), dim3(NTHR), kargs, LDS_BYTES, stream);
    if (e != hipSuccess) fprintf(stderr, "kernel_launch: cooperative launch failed: %s (grid %d)\n", hipGetErrorString(e), grid);
#else
    for (int p = 0; p < NPH; ++p) { a.ph_lo = p; a.ph_hi = p + 1; hipLaunchKernelGGL(trunk_fwd, dim3(grid), dim3(NTHR), LDS_BYTES, stream, a); }
#endif
}
```

```cpp
#include <hip/hip_runtime.h>
#include <hip/hip_cooperative_groups.h>
#include <cstdio>
#include <cstdint>
namespace cg = cooperative_groups;
#ifndef MK_SINGLE
#define MK_SINGLE 1
#endif
namespace pg8 {
#define PG8_LAS __attribute__((address_space(3)))
typedef unsigned short bf16_t;
typedef short bf16x8 __attribute__((ext_vector_type(8)));
typedef float f32x4 __attribute__((ext_vector_type(4)));
typedef unsigned u32x4 __attribute__((ext_vector_type(4)));
constexpr int BM = 256, BK = 64, HALF = 128, HTB = HALF * BK * 2  , STAGE_BYTES = 8 * HTB, NXCD = 8, WGM = 8;

__host__ __device__ __forceinline__ int lds_byte(int r, int c) { const int st = (r >> 4) * 2 + (c >> 5), rr = r & 15, cc = c & 31, ob = rr * 64 + cc * 2; return st * 1024 + (ob ^ (((ob >> 9) & 1) << 5)); }
__host__ __device__ __forceinline__ void stage_rc(int b, int& R, int& C) { const int st = b / 1024, sb = b % 1024, swz = sb ^ (((sb >> 9) & 1) << 5); R = (st >> 1) * 16 + swz / 64; C = (st & 1) * 32 + (swz % 64) / 2; }
__host__ __device__ __forceinline__ int perm32(int rho) { const int n = rho >> 4, i = rho & 15; return 8 * (i >> 2) + 4 * n + (i & 3); }

struct Unit { int pm, pn; };
struct Gemm { const bf16_t* A; const bf16_t* Bt; int M, N, K; };

struct StaticOrder {
    int nM, nN, nwg, G, c;
    __host__ __device__ void init(int M, int N, int G_, int c_) { nM = M / BM; nN = N / BM; nwg = nM * nN; G = G_; c = c_; }
    __host__ __device__ bool next(int i, Unit& u) const {
        const long L = (long)i * G + c; if (L >= nwg) return false;
        int wgid = (int)L; { const int q = nwg / NXCD, r = nwg % NXCD, xcd = wgid % NXCD, off = wgid / NXCD; wgid = (xcd < r ? xcd * (q + 1) : r * (q + 1) + (xcd - r) * q) + off; }
        const int nig = WGM * nN, gid = wgid / nig, fm = gid * WGM, gsz = (nM - fm) < WGM ? (nM - fm) : WGM;
        u.pm = fm + ((wgid % nig) % gsz); u.pn = (wgid % nig) / gsz; return true;
    }
    __device__ __forceinline__ void a_ready(const Unit&) const {}
    __device__ __forceinline__ void done(const Unit&) const {}
};
__device__ __forceinline__ unsigned cvt_pk_bf16(float lo, float hi) { unsigned r; asm volatile("v_cvt_pk_bf16_f32 %0, %1, %2" : "=v"(r) : "v"(lo), "v"(hi)); return r; }
typedef float f32x2 __attribute__((ext_vector_type(2)));
typedef unsigned u32x2 __attribute__((ext_vector_type(2)));
__device__ __forceinline__ float ror1(float v) { return __int_as_float(__builtin_amdgcn_update_dpp(0, __float_as_int(v), 0x121, 0xf, 0xf, true)); }
__device__ __forceinline__ float ror2(float v) { return __int_as_float(__builtin_amdgcn_update_dpp(0, __float_as_int(v), 0x122, 0xf, 0xf, true)); }
template <int K_> __device__ __forceinline__ float shr_dpp(float v) { return __int_as_float(__builtin_amdgcn_update_dpp(0, __float_as_int(v), 0x110 + K_, 0xf, 0xf, true)); }
__device__ __forceinline__ float bc15_dpp(float v) { return __int_as_float(__builtin_amdgcn_update_dpp(0, __float_as_int(v), 0x15F, 0xf, 0xf, false)); }
template <int K_> __device__ __forceinline__ float shr_keep(float old, float v) { return __int_as_float(__builtin_amdgcn_update_dpp(__float_as_int(old), __float_as_int(v), 0x110 + K_, 0xf, 0xf, false)); }
template <int mode, int KC_> struct Epi {
    static constexpr bool PERM = true, AFTER_DRAIN = false; static constexpr int KC = KC_;
    bf16_t* O; int ldc; const float* ssp_in;
    bf16_t* Ub; const float* cw;
    bf16_t* hb; float* ssp_out;
    const bf16_t* resb;
    float* out; const float* res; const float* ss;
    bf16_t* Q; float* LOGF; bf16_t* V; bf16_t* G; const float* lbt;
    bf16_t* KE;
    __device__ __forceinline__ void operator()(const f32x4 (&acc)[2][2][4][2], const Unit& u, int wr, int wc, int fr_, int fq_) const {
        int l_; asm volatile("v_mbcnt_lo_u32_b32 %0, -1, 0\n\tv_mbcnt_hi_u32_b32 %0, -1, %0" : "=v"(l_));
        const int fr = l_ & 15, fq = l_ >> 4; (void)fr_; (void)fq_;
        const int row0 = u.pm * BM + wr * 64 + fr;
        if constexpr (mode == 0) {
            const int col0 = u.pn * BM + wc * 32 + 8 * fq;
            float rs[2][4];
#pragma unroll
            for (int ai = 0; ai < 2; ++ai)
#pragma unroll
                for (int m = 0; m < 4; ++m) rs[ai][m] = ssp_in ? ssp_in[row0 + ai * HALF + m * 16] : 1.0f;
            if (ssp_in) {
#pragma unroll
                for (int ai = 0; ai < 2; ++ai)
#pragma unroll
                    for (int m = 0; m < 4; ++m) rs[ai][m] = __builtin_amdgcn_rsqf(rs[ai][m] * (1.0f / 2048.0f) + 1e-6f); }
#pragma unroll
            for (int ai = 0; ai < 2; ++ai)
#pragma unroll
                for (int m = 0; m < 4; ++m) { const int row = row0 + ai * HALF + m * 16; bf16_t* rowp = O + (size_t)row * ldc + col0;
#pragma unroll
                    for (int bj = 0; bj < 2; ++bj) { const f32x4 v0 = acc[ai][bj][m][0] * rs[ai][m], v1 = acc[ai][bj][m][1] * rs[ai][m];
                        u32x4 w; w.x = cvt_pk_bf16(v0[0], v0[1]); w.y = cvt_pk_bf16(v0[2], v0[3]); w.z = cvt_pk_bf16(v1[0], v1[1]); w.w = cvt_pk_bf16(v1[2], v1[3]);
                        *(u32x4*)(rowp + bj * HALF) = w; } }
        } else if constexpr (mode == 1) {
            const int col0 = u.pn * BM + wc * 32 + 8 * fq;
            float sc8[2][4];
#pragma unroll
            for (int ai = 0; ai < 2; ++ai)
#pragma unroll
                for (int m = 0; m < 4; ++m) sc8[ai][m] = ss ? ss[row0 + ai * HALF + m * 16] : 1.0f;
            if (ss) {
#pragma unroll
                for (int ai = 0; ai < 2; ++ai)
#pragma unroll
                    for (int m = 0; m < 4; ++m) sc8[ai][m] = __builtin_amdgcn_rsqf(sc8[ai][m] * (1.0f / 2048.0f) + 1e-6f); }
#pragma unroll
            for (int ai = 0; ai < 2; ++ai)
#pragma unroll
                for (int m = 0; m < 4; ++m) { const int row = row0 + ai * HALF + m * 16; const size_t off = (size_t)row * 2048 + col0;
                    const float sc = sc8[ai][m];
                    float ssq = 0.f;
#pragma unroll
                    for (int bj = 0; bj < 2; ++bj) { f32x4 r0, r1;
                        if (resb) { const u32x4 rw = *(const u32x4*)(resb + off + bj * HALF);
                            r0 = (f32x4){__uint_as_float(rw.x << 16), __uint_as_float(rw.x & 0xffff0000u), __uint_as_float(rw.y << 16), __uint_as_float(rw.y & 0xffff0000u)};
                            r1 = (f32x4){__uint_as_float(rw.z << 16), __uint_as_float(rw.z & 0xffff0000u), __uint_as_float(rw.w << 16), __uint_as_float(rw.w & 0xffff0000u)}; }
                        else { r0 = *(const f32x4*)(res + off + bj * HALF); r1 = *(const f32x4*)(res + off + bj * HALF + 4); }
                        const f32x4 o0 = r0 + acc[ai][bj][m][0] * sc, o1 = r1 + acc[ai][bj][m][1] * sc;
                        if (out) { *(f32x4*)(out + off + bj * HALF) = o0; *(f32x4*)(out + off + bj * HALF + 4) = o1; }
                        ssq += ((o0[0] * o0[0] + o0[1] * o0[1]) + (o0[2] * o0[2] + o0[3] * o0[3])) + ((o1[0] * o1[0] + o1[1] * o1[1]) + (o1[2] * o1[2] + o1[3] * o1[3]));
                        if (hb) { u32x4 w; w.x = cvt_pk_bf16(o0[0], o0[1]); w.y = cvt_pk_bf16(o0[2], o0[3]); w.z = cvt_pk_bf16(o1[0], o1[1]); w.w = cvt_pk_bf16(o1[2], o1[3]); *(u32x4*)(hb + off + bj * HALF) = w; } }
                    if (ssp_out) { ssq += __shfl_xor(ssq, 16); ssq += __shfl_xor(ssq, 32); if (fq == 0) unsafeAtomicAdd(ssp_out + row, ssq); }
                    asm volatile("" ::: "memory"); }
        } else if constexpr (mode == 3) {
            const int cbase = u.pn * 128 + wc * 32 + 8 * fq;
            f32x4 WG[2][3], WV[2][3]; float rsa[2][4];
#pragma unroll
            for (int n = 0; n < 2; ++n)
#pragma unroll
                for (int k = 0; k < 3; ++k) { WG[n][k] = *(const f32x4*)(cw + k * 11264 + cbase + 4 * n); WV[n][k] = *(const f32x4*)(cw + k * 11264 + 5632 + cbase + 4 * n); }
#pragma unroll
            for (int ai = 0; ai < 2; ++ai)
#pragma unroll
                for (int m = 0; m < 4; ++m) rsa[ai][m] = ssp_in[row0 + ai * HALF + m * 16];
#pragma unroll
            for (int ai = 0; ai < 2; ++ai) {
                float rs[4];
#pragma unroll
                for (int m = 0; m < 4; ++m) rs[m] = __builtin_amdgcn_rsqf(rsa[ai][m] * (1.0f / 2048.0f) + 1e-6f);
                unsigned op[2][4][2];
#pragma unroll
                for (int n = 0; n < 2; ++n) {
                    const f32x4 wg0 = WG[n][0], wg1 = WG[n][1], wg2 = WG[n][2], wv0 = WV[n][0], wv1 = WV[n][1], wv2 = WV[n][2];
#pragma unroll
                    for (int jp = 0; jp < 2; ++jp) {
                        const f32x2 g0 = {wg0[2 * jp], wg0[2 * jp + 1]}, g1 = {wg1[2 * jp], wg1[2 * jp + 1]}, g2 = {wg2[2 * jp], wg2[2 * jp + 1]};
                        const f32x2 h0 = {wv0[2 * jp], wv0[2 * jp + 1]}, h1 = {wv1[2 * jp], wv1[2 * jp + 1]}, h2 = {wv2[2 * jp], wv2[2 * jp + 1]};
                        f32x2 cg[4], cv[4];
                        { f32x2 x[4];
#pragma unroll
                          for (int m = 0; m < 4; ++m) x[m] = (f32x2){acc[ai][0][m][n][2 * jp], acc[ai][0][m][n][2 * jp + 1]} * rs[m];
                          f32x2 q1 = {0.f, 0.f}, q2 = {0.f, 0.f};
#pragma unroll
                          for (int m = 0; m < 4; ++m) { f32x2 x1, x2; x1.x = shr_keep<1>(q1.x, x[m].x); x1.y = shr_keep<1>(q1.y, x[m].y); x2.x = shr_keep<2>(q2.x, x[m].x); x2.y = shr_keep<2>(q2.y, x[m].y);
                              cg[m] = g0 * x2 + g1 * x1 + g2 * x[m]; if (m < 3) { q1.x = ror1(x[m].x); q1.y = ror1(x[m].y); q2.x = ror2(x[m].x); q2.y = ror2(x[m].y); } } }
                        { f32x2 y[4];
#pragma unroll
                          for (int m = 0; m < 4; ++m) y[m] = (f32x2){acc[ai][1][m][n][2 * jp], acc[ai][1][m][n][2 * jp + 1]} * rs[m];
                          f32x2 q1 = {0.f, 0.f}, q2 = {0.f, 0.f};
#pragma unroll
                          for (int m = 0; m < 4; ++m) { f32x2 y1, y2; y1.x = shr_keep<1>(q1.x, y[m].x); y1.y = shr_keep<1>(q1.y, y[m].y); y2.x = shr_keep<2>(q2.x, y[m].x); y2.y = shr_keep<2>(q2.y, y[m].y);
                              cv[m] = h0 * y2 + h1 * y1 + h2 * y[m]; if (m < 3) { q1.x = ror1(y[m].x); q1.y = ror1(y[m].y); q2.x = ror2(y[m].x); q2.y = ror2(y[m].y); } } }
#pragma unroll
                        for (int m = 0; m < 4; ++m) { f32x2 sg; sg.x = __builtin_amdgcn_rcpf(1.0f + __expf(-cg[m].x)); sg.y = __builtin_amdgcn_rcpf(1.0f + __expf(-cg[m].y));
                            const f32x2 o = cg[m] * sg * cv[m]; op[n][m][jp] = cvt_pk_bf16(o.x, o.y); }
                        __builtin_amdgcn_sched_barrier(0);
                    }
                }
#pragma unroll
                for (int m = 0; m < 4; ++m) { const size_t row = (size_t)(row0 + ai * HALF + m * 16);
                    if (m > 0 || fr >= 2) { u32x4 w; w.x = op[0][m][0]; w.y = op[0][m][1]; w.z = op[1][m][0]; w.w = op[1][m][1]; *(u32x4*)(O + row * 5632 + cbase) = w; }
                    if ((m == 0 && fr < 2) || (m == 3 && fr >= 14)) { const f32x4 xg0 = acc[ai][0][m][0] * rs[m], xg1 = acc[ai][0][m][1] * rs[m], yv0 = acc[ai][1][m][0] * rs[m], yv1 = acc[ai][1][m][1] * rs[m];
                        u32x4 w; w.x = cvt_pk_bf16(xg0[0], xg0[1]); w.y = cvt_pk_bf16(xg0[2], xg0[3]); w.z = cvt_pk_bf16(xg1[0], xg1[1]); w.w = cvt_pk_bf16(xg1[2], xg1[3]); *(u32x4*)(Ub + row * 11264 + cbase) = w;
                        w.x = cvt_pk_bf16(yv0[0], yv0[1]); w.y = cvt_pk_bf16(yv0[2], yv0[3]); w.z = cvt_pk_bf16(yv1[0], yv1[1]); w.w = cvt_pk_bf16(yv1[2], yv1[3]); *(u32x4*)(Ub + row * 11264 + 5632 + cbase) = w; } }
                __builtin_amdgcn_sched_barrier(0);
            }
        } else if constexpr (mode == 4) {
            if (u.pn & 4) {
                const int t = 16 + (u.pn >> 3) * 4 + (u.pn & 3); const bool isv = t < 24; bf16_t* base = isv ? V : G; const int col0 = ((t - 16) & 7) * BM + wc * 32 + 8 * fq;
#pragma unroll
                for (int ai = 0; ai < 2; ++ai)
#pragma unroll
                    for (int m = 0; m < 4; ++m) { bf16_t* rowp = base + (size_t)(row0 + ai * HALF + m * 16) * 2048 + col0;
#pragma unroll
                        for (int bj = 0; bj < 2; ++bj) { f32x4 v0 = acc[ai][bj][m][0], v1 = acc[ai][bj][m][1];
                            if (!isv) {
#pragma unroll
                                for (int j = 0; j < 4; ++j) { v0[j] = v0[j] * __builtin_amdgcn_rcpf(1.0f + __expf(-v0[j])); v1[j] = v1[j] * __builtin_amdgcn_rcpf(1.0f + __expf(-v1[j])); } }
                            u32x4 w; w.x = cvt_pk_bf16(v0[0], v0[1]); w.y = cvt_pk_bf16(v0[2], v0[3]); w.z = cvt_pk_bf16(v1[0], v1[1]); w.w = cvt_pk_bf16(v1[2], v1[3]);
                            *(u32x4*)(rowp + bj * HALF) = w; } }
            } else {
                const int h = (u.pn >> 3) * 4 + (u.pn & 3), cl = wc * 32 + 8 * fq;
                f32x4 lb[2];
#pragma unroll
                for (int n = 0; n < 2; ++n) { const float* p = lbt + h * 128 + cl + 4 * n; const f32x4 t0 = *(const f32x4*)p, t1 = *(const f32x4*)(p + 2048), t2 = *(const f32x4*)(p + 4096);
#pragma unroll
                    for (int j = 0; j < 4; ++j) { const float mx = fmaxf(t0[j], fmaxf(t1[j], t2[j])); const float e0 = __expf(t0[j] - mx), e1 = __expf(t1[j] - mx), e2 = __expf(t2[j] - mx); lb[n][j] = e0 / (e0 + e1 + e2); } }
#pragma unroll
                for (int ai = 0; ai < 2; ++ai) {
                    const int m0 = u.pm * BM + ai * HALF + wr * 64;
                    const int task = ((m0 >> 12) * 16 + h) * 64 + ((m0 & 4095) >> 6);
                    unsigned qp[2][4][2], kp[2][4][2];
#pragma unroll
                    for (int n = 0; n < 2; ++n) {
                        f32x4 er, ebr, dec;
#pragma unroll
                        for (int jp = 0; jp < 2; ++jp) {
                            float qo[4][2], ko[4][2];
#pragma unroll
                            for (int e = 0; e < 2; ++e) { const int j = jp * 2 + e; const float l = lb[n][j];
                                float kk[4], bb[4];
#pragma unroll
                                for (int m = 0; m < 4; ++m) { const float a = acc[ai][1][m][n][j]; const float sg = __builtin_amdgcn_rcpf(1.0f + __expf(-a)); const float f = l + (1.0f - l) * sg; kk[m] = 1.0f - f;
                                    float s = __builtin_amdgcn_logf(f) * 0.6931471805599453f;     s += shr_dpp<1>(s); s += shr_dpp<2>(s); s += shr_dpp<4>(s); s += shr_dpp<8>(s); bb[m] = s; }
                                const float t0 = bc15_dpp(bb[0]), t1 = bc15_dpp(bb[1]), t2 = bc15_dpp(bb[2]), t3 = bc15_dpp(bb[3]);
                                const float c1 = t0 + t1; bb[1] += t0; bb[2] += c1; bb[3] += c1 + t2; const float bl = (c1 + t2) + t3;
                                const float r = c1;
#pragma unroll
                                for (int m = 0; m < 4; ++m) { const float aq = acc[ai][0][m][n][j]; const float qv = aq * __builtin_amdgcn_rcpf(1.0f + __expf(-aq)) * 0.08838834764831845f; const float e1 = __expf(bb[m] - r);
                                    qo[m][e] = qv * e1; ko[m][e] = kk[m] * __builtin_amdgcn_rcpf(e1); }
                                er[j] = __expf(r); ebr[j] = __expf(bl - r); dec[j] = __expf(bl);
                            }
#pragma unroll
                            for (int m = 0; m < 4; ++m) { qp[n][m][jp] = cvt_pk_bf16(qo[m][0], qo[m][1]); kp[n][m][jp] = cvt_pk_bf16(ko[m][0], ko[m][1]); }
                        }
                        if (fr == 0) { float* vp = LOGF + (size_t)task * 128 + cl + 4 * n; *(f32x4*)vp = er; *(f32x4*)(vp + 2048 * 128) = ebr; *(f32x4*)(vp + 2 * 2048 * 128) = dec; }
                        __builtin_amdgcn_sched_barrier(0);
                    }
#pragma unroll
                    for (int m = 0; m < 4; ++m) { const size_t off = (size_t)(row0 + ai * HALF + m * 16) * 2048 + h * 128 + cl;
                        u32x4 w; w.x = qp[0][m][0]; w.y = qp[0][m][1]; w.z = qp[1][m][0]; w.w = qp[1][m][1]; *(u32x4*)(Q + off) = w;
                        w.x = kp[0][m][0]; w.y = kp[0][m][1]; w.z = kp[1][m][0]; w.w = kp[1][m][1]; *(u32x4*)(KE + off) = w; }
                }
            }
        } else {
            const int sec = u.pn >> 3, col0 = (u.pn & 7) * BM + wc * 32 + 8 * fq;
            if (sec == 2) {
#pragma unroll
                for (int ai = 0; ai < 2; ++ai)
#pragma unroll
                    for (int m = 0; m < 4; ++m) { bf16_t* rowp = V + (size_t)(row0 + ai * HALF + m * 16) * 2048 + col0;
#pragma unroll
                        for (int bj = 0; bj < 2; ++bj) { const f32x4 v0 = acc[ai][bj][m][0], v1 = acc[ai][bj][m][1];
                            u32x4 w; w.x = cvt_pk_bf16(v0[0], v0[1]); w.y = cvt_pk_bf16(v0[2], v0[3]); w.z = cvt_pk_bf16(v1[0], v1[1]); w.w = cvt_pk_bf16(v1[2], v1[3]);
                            *(u32x4*)(rowp + bj * HALF) = w; } }
            } else if (sec == 1) {
                f32x4 lb[2][2];
#pragma unroll
                for (int bj = 0; bj < 2; ++bj)
#pragma unroll
                    for (int n = 0; n < 2; ++n) { const float* p = lbt + col0 + bj * HALF + 4 * n; const f32x4 t0 = *(const f32x4*)p, t1 = *(const f32x4*)(p + 2048), t2 = *(const f32x4*)(p + 4096);
#pragma unroll
                        for (int j = 0; j < 4; ++j) { const float mx = fmaxf(t0[j], fmaxf(t1[j], t2[j])); const float e0 = __expf(t0[j] - mx), e1 = __expf(t1[j] - mx), e2 = __expf(t2[j] - mx); lb[bj][n][j] = e0 / (e0 + e1 + e2); } }
#pragma unroll
                for (int ai = 0; ai < 2; ++ai)
#pragma unroll
                    for (int m = 0; m < 4; ++m) { float* rowp = LOGF + (size_t)(row0 + ai * HALF + m * 16) * 2048 + col0;
#pragma unroll
                        for (int bj = 0; bj < 2; ++bj)
#pragma unroll
                            for (int n = 0; n < 2; ++n) { f32x4 o;
#pragma unroll
                                for (int j = 0; j < 4; ++j) { const float a = acc[ai][bj][m][n][j]; const float sg = __builtin_amdgcn_rcpf(1.0f + __expf(-a)); const float l = lb[bj][n][j]; o[j] = __logf(l + (1.0f - l) * sg); }
                                *(f32x4*)(rowp + bj * HALF + 4 * n) = o; } }
            } else {
                bf16_t* base = sec == 0 ? Q : G; const float sc = sec == 0 ? 0.08838834764831845f : 1.0f;
#pragma unroll
                for (int ai = 0; ai < 2; ++ai)
#pragma unroll
                    for (int m = 0; m < 4; ++m) { bf16_t* rowp = base + (size_t)(row0 + ai * HALF + m * 16) * 2048 + col0;
#pragma unroll
                        for (int bj = 0; bj < 2; ++bj) { f32x4 v0 = acc[ai][bj][m][0], v1 = acc[ai][bj][m][1];
#pragma unroll
                            for (int j = 0; j < 4; ++j) { v0[j] = v0[j] * sc * __builtin_amdgcn_rcpf(1.0f + __expf(-v0[j])); v1[j] = v1[j] * sc * __builtin_amdgcn_rcpf(1.0f + __expf(-v1[j])); }
                            u32x4 w; w.x = cvt_pk_bf16(v0[0], v0[1]); w.y = cvt_pk_bf16(v0[2], v0[3]); w.z = cvt_pk_bf16(v1[0], v1[1]); w.w = cvt_pk_bf16(v1[2], v1[3]);
                            *(u32x4*)(rowp + bj * HALF) = w; } }
            }
        }
    }
};

template <class Epi, class Sched, bool ALIGN_EPI = false, bool SP2 = false>
__device__ __forceinline__ void gemm_phase(PG8_LAS unsigned char* lds, const Gemm g, const Sched& S, const Epi& E, const int wid) {
    int lane_; asm volatile("v_mbcnt_lo_u32_b32 %0, -1, 0\n\tv_mbcnt_hi_u32_b32 %0, -1, %0" : "=v"(lane_));
    const int lane = lane_, tid = wid * 64 + lane, wr = wid >> 2, wc = wid & 3, fr = lane & 15, fq = lane >> 4;
    constexpr int K = Epi::KC, nt = K / BK;
    unsigned voffA[2], voffB[2];
#pragma unroll
    for (int i = 0; i < 2; ++i) { int R, C; stage_rc(tid * 16 + i * 8192, R, C); const int Rb = Epi::PERM ? ((R & ~31) + perm32(R & 31)) : R;
        voffA[i] = (unsigned)(R * K + C) * 2u; voffB[i] = (unsigned)(Rb * K + C) * 2u; }
    const size_t kstep = (size_t)(BK * 2);
    const size_t hstep = (size_t)HALF * K * 2;
    const size_t tstep = 2 * hstep;
    const unsigned ldsw = (unsigned)wid * 1024u;
    const int aoff = lds_byte(wr * 64 + fr, fq * 8), boff = lds_byte(wc * 32 + fr, fq * 8);
#define PG8_SA(b, h) (((b) * 2 + (h)) * HTB)
#define PG8_SB(b, h) ((4 + (b) * 2 + (h)) * HTB)
#define PG8_STAGE(bufoff, gbase, voff) do { _Pragma("unroll") for (int _i = 0; _i < 2; ++_i) \
        __builtin_amdgcn_global_load_lds((const unsigned*)((const char*)(gbase) + (voff)[_i]), (PG8_LAS unsigned*)(lds + (bufoff) + ldsw + _i * 8192), 16, 0, 0); } while (0)
#define PG8_LDA(dst, b, h) do { _Pragma("unroll") for (int m = 0; m < 4; ++m) _Pragma("unroll") for (int k = 0; k < 2; ++k) dst[m][k] = *(const PG8_LAS bf16x8*)(lds + PG8_SA(b, h) + aoff + m * 2048 + k * 1024); } while (0)
#define PG8_LDB(dst, b, h) do { _Pragma("unroll") for (int n = 0; n < 2; ++n) _Pragma("unroll") for (int k = 0; k < 2; ++k) dst[n][k] = *(const PG8_LAS bf16x8*)(lds + PG8_SB(b, h) + boff + n * 2048 + k * 1024); } while (0)
#define PG8_MMA(ai, bj, At, Bt) do { __builtin_amdgcn_s_setprio(1); _Pragma("unroll") for (int m = 0; m < 4; ++m) _Pragma("unroll") for (int n = 0; n < 2; ++n) _Pragma("unroll") for (int k = 0; k < 2; ++k) \
        acc[ai][bj][m][n] = __builtin_amdgcn_mfma_f32_16x16x32_bf16(Bt[n][k], At[m][k], acc[ai][bj][m][n], 0, 0, 0); __builtin_amdgcn_s_setprio(0); } while (0)
#define PG8_WAIT_V(n) asm volatile("s_waitcnt vmcnt(" #n ")" ::: "memory")
#define PG8_WAIT_L(n) asm volatile("s_waitcnt lgkmcnt(" #n ")" ::: "memory")
#define PG8_BAR __builtin_amdgcn_s_barrier()
#define PG8_SCHED __builtin_amdgcn_sched_barrier(0)
    Unit cur, nxt; int ui = 0;
    if (!S.next(0, cur)) return;
    f32x4 acc[2][2][4][2];
#pragma unroll
    for (int a = 0; a < 2; ++a)
#pragma unroll
        for (int b = 0; b < 2; ++b)
#pragma unroll
            for (int m = 0; m < 4; ++m)
#pragma unroll
                for (int n = 0; n < 2; ++n) acc[a][b][m][n] = (f32x4){0.f, 0.f, 0.f, 0.f};
    bf16x8 At[4][2], B0[2][2], B1[2][2];
    const char* cA = (const char*)g.A + (size_t)cur.pm * tstep; const char* cB = (const char*)g.Bt + (size_t)cur.pn * tstep;
    S.a_ready(cur);
    if constexpr (SP2) {
        PG8_STAGE(PG8_SB(0, 0), cB, voffB); PG8_STAGE(PG8_SB(0, 1), cB + hstep, voffB); PG8_STAGE(PG8_SA(0, 0), cA, voffA); PG8_STAGE(PG8_SA(0, 1), cA + hstep, voffA);
        if (wr == 1) PG8_BAR;
        PG8_WAIT_V(2); PG8_BAR;
        PG8_STAGE(PG8_SB(1, 0), cB + kstep, voffB); PG8_STAGE(PG8_SA(1, 0), cA + kstep, voffA); PG8_STAGE(PG8_SB(1, 1), cB + hstep + kstep, voffB);
        PG8_WAIT_V(6); PG8_BAR;
    } else {
        PG8_STAGE(PG8_SB(0, 0), cB, voffB); PG8_STAGE(PG8_SA(0, 0), cA, voffA); PG8_STAGE(PG8_SB(0, 1), cB + hstep, voffB); PG8_STAGE(PG8_SA(0, 1), cA + hstep, voffA);
        if (wr == 1) PG8_BAR;
        PG8_WAIT_V(4); PG8_BAR;
        PG8_STAGE(PG8_SB(1, 0), cB + kstep, voffB); PG8_STAGE(PG8_SA(1, 0), cA + kstep, voffA); PG8_STAGE(PG8_SB(1, 1), cB + hstep + kstep, voffB);
        PG8_WAIT_V(6); PG8_BAR;
    }
    for (;;) {
        const bool has_next = S.next(ui + 1, nxt);
        const char* nA = has_next ? (const char*)g.A + (size_t)nxt.pm * tstep : cA; const char* nB = has_next ? (const char*)g.Bt + (size_t)nxt.pn * tstep : cB;
        for (int t = 0; t < nt; t += 2) {
            const bool last = (t == nt - 2);
            const char* a1 = cA + (size_t)(t + 1) * kstep;
            const char* a2 = last ? nA : cA + (size_t)(t + 2) * kstep; const char* b2 = last ? nB : cB + (size_t)(t + 2) * kstep;
            const char* a3 = a2 + kstep; const char* b3 = b2 + kstep;
            if (last && has_next) S.a_ready(nxt);
            if constexpr (SP2) {
            PG8_LDB(B0, 0, 0); PG8_LDB(B1, 0, 1); PG8_SCHED; PG8_LDA(At, 0, 0); PG8_STAGE(PG8_SA(1, 1), a1 + hstep, voffA);
            PG8_WAIT_V(8); PG8_WAIT_L(0); PG8_BAR; PG8_MMA(0, 0, At, B0); PG8_MMA(0, 1, At, B1); PG8_BAR; PG8_SCHED;
            PG8_LDA(At, 0, 1); PG8_STAGE(PG8_SB(0, 0), b2, voffB); PG8_STAGE(PG8_SB(0, 1), b2 + hstep, voffB); PG8_STAGE(PG8_SA(0, 0), a2, voffA);
            PG8_WAIT_V(8); PG8_WAIT_L(0); PG8_BAR; PG8_MMA(1, 0, At, B0); PG8_MMA(1, 1, At, B1); PG8_BAR; PG8_SCHED;
            PG8_LDB(B0, 1, 0); PG8_LDB(B1, 1, 1); PG8_SCHED; PG8_LDA(At, 1, 0); PG8_STAGE(PG8_SA(0, 1), a2 + hstep, voffA);
            PG8_WAIT_V(8); PG8_WAIT_L(0); PG8_BAR; PG8_MMA(0, 0, At, B0); PG8_MMA(0, 1, At, B1); PG8_BAR; PG8_SCHED;
            PG8_LDA(At, 1, 1); PG8_STAGE(PG8_SB(1, 0), b3, voffB); PG8_STAGE(PG8_SB(1, 1), b3 + hstep, voffB); PG8_STAGE(PG8_SA(1, 0), a3, voffA);
            PG8_WAIT_V(8); PG8_WAIT_L(0); PG8_BAR; PG8_MMA(1, 0, At, B0); PG8_MMA(1, 1, At, B1); PG8_BAR; PG8_SCHED;
            } else {
            PG8_LDB(B0, 0, 0); PG8_SCHED; PG8_LDA(At, 0, 0); PG8_STAGE(PG8_SA(1, 1), a1 + hstep, voffA);
            PG8_WAIT_L(8); PG8_BAR; PG8_WAIT_L(0); PG8_MMA(0, 0, At, B0); PG8_BAR; PG8_SCHED;
            PG8_LDB(B1, 0, 1); PG8_STAGE(PG8_SB(0, 0), b2, voffB);
            PG8_BAR; PG8_WAIT_L(0); PG8_MMA(0, 1, At, B1); PG8_BAR;
            PG8_LDA(At, 0, 1); PG8_STAGE(PG8_SA(0, 0), a2, voffA);
            PG8_BAR; PG8_WAIT_L(0); PG8_MMA(1, 0, At, B0); PG8_BAR; PG8_SCHED;
            PG8_STAGE(PG8_SB(0, 1), b2 + hstep, voffB);
            PG8_WAIT_V(6); PG8_BAR; PG8_MMA(1, 1, At, B1); PG8_BAR;
            PG8_LDB(B0, 1, 0); PG8_SCHED; PG8_LDA(At, 1, 0); PG8_STAGE(PG8_SA(0, 1), a2 + hstep, voffA);
            PG8_WAIT_L(8); PG8_BAR; PG8_WAIT_L(0); PG8_MMA(0, 0, At, B0); PG8_BAR; PG8_SCHED;
            PG8_LDB(B1, 1, 1); PG8_STAGE(PG8_SB(1, 0), b3, voffB);
            PG8_BAR; PG8_WAIT_L(0); PG8_MMA(0, 1, At, B1); PG8_BAR;
            PG8_LDA(At, 1, 1); PG8_STAGE(PG8_SA(1, 0), a3, voffA);
            PG8_BAR; PG8_WAIT_L(0); PG8_MMA(1, 0, At, B0); PG8_BAR; PG8_SCHED;
            PG8_STAGE(PG8_SB(1, 1), b3 + hstep, voffB);
            PG8_WAIT_V(6); PG8_BAR; PG8_MMA(1, 1, At, B1); PG8_BAR;
            }
        }
        if constexpr (ALIGN_EPI) { if (wr == 0) PG8_BAR; }
        if constexpr (!Epi::AFTER_DRAIN) { E(acc, cur, wr, wc, fr, fq); S.done(cur); }
        if (!has_next) break;
#pragma unroll
        for (int a = 0; a < 2; ++a)
#pragma unroll
            for (int b = 0; b < 2; ++b)
#pragma unroll
                for (int m = 0; m < 4; ++m)
#pragma unroll
                    for (int n = 0; n < 2; ++n) acc[a][b][m][n] = (f32x4){0.f, 0.f, 0.f, 0.f};
        cur = nxt; cA = nA; cB = nB; ++ui;
        if constexpr (ALIGN_EPI) { if (wr == 1) PG8_BAR; }
    }
    PG8_WAIT_V(0);
    if constexpr (!ALIGN_EPI) { if (wr == 0) PG8_BAR; }
    PG8_BAR;
    if constexpr (Epi::AFTER_DRAIN) { E.fused(acc, cur, wr, wc, fr, fq, lds, wid, lane); S.done(cur); }
#undef PG8_SA
#undef PG8_SB
#undef PG8_STAGE
#undef PG8_LDA
#undef PG8_LDB
#undef PG8_MMA
#undef PG8_WAIT_V
#undef PG8_WAIT_L
#undef PG8_BAR
#undef PG8_SCHED
}
}

#define LAS __attribute__((address_space(3)))
typedef unsigned short bf16;
typedef short bf16x8 __attribute__((ext_vector_type(8)));
typedef float f32x4 __attribute__((ext_vector_type(4)));
typedef unsigned u32x4 __attribute__((ext_vector_type(4)));
typedef unsigned u32x2 __attribute__((ext_vector_type(2)));
constexpr int NWAVES = 8, NTHR = 512;
constexpr int SEQ = 4096, D = 2048, M = 8192, HD = 128, FF = 5632, NIN = 8192, NSC = 6144, NUP = 11264;
constexpr int NTASK = 2048;
constexpr float EPS = 1e-6f;
constexpr int LDS_BYTES = 147456;

constexpr size_t MiB = 1u << 20;
constexpr size_t WS_WIN = 1 * MiB, WS_WOH = WS_WIN + 32 * MiB, WS_WUP0 = WS_WOH + 8 * MiB, WS_WUP1 = WS_WUP0 + 44 * MiB, WS_WDN0 = WS_WUP1 + 44 * MiB, WS_WDN1 = WS_WDN0 + 22 * MiB,
                 WS_WSI = WS_WDN1 + 22 * MiB, WS_WSO = WS_WSI + 24 * MiB, WS_XN = WS_WSO + 8 * MiB, WS_R = WS_XN + 32 * MiB;
constexpr size_t WS_Q = WS_R, WS_LOGF = WS_Q + 32 * MiB  , WS_V = WS_LOGF + 64 * MiB  , WS_G = WS_V + 32 * MiB, WS_UT = WS_G + 32 * MiB, WS_SP = WS_UT + 128 * MiB,
                 WS_DEC = WS_SP + 64 * MiB, WS_SS = WS_DEC + 1 * MiB, WS_R_END = WS_SS + 1 * MiB;
constexpr size_t WS_U = WS_R, WS_ACT = WS_U + 176 * MiB;
constexpr size_t WS_P2 = WS_R, WS_Y = WS_P2 + 96 * MiB;
constexpr size_t WS_SSP = WS_R_END, WS_QE2 = WS_SSP + 1 * MiB, WS_OI = WS_QE2 + 32 * MiB, WS_END = WS_OI + 64 * MiB;
static_assert(WS_ACT + 88 * MiB <= WS_END && WS_Y + 32 * MiB <= WS_END, "ws map");

typedef __bf16 bf16x2_t __attribute__((ext_vector_type(2)));
__device__ __forceinline__ unsigned pk_bf16(float lo, float hi) { bf16x2_t v = {(__bf16)lo, (__bf16)hi}; return __builtin_bit_cast(unsigned, v); }
__device__ __forceinline__ float bf_lo(unsigned w) { return __uint_as_float(w << 16); }
__device__ __forceinline__ float bf_hi(unsigned w) { return __uint_as_float(w & 0xffff0000u); }
__device__ __forceinline__ float bf1(bf16 h) { return __uint_as_float(((unsigned)h) << 16); }
__device__ __forceinline__ float wave_sum(float v) {
#pragma unroll
    for (int o = 1; o < 64; o <<= 1) v += __shfl_xor(v, o);
    return v;
}
__device__ __forceinline__ int lane_id() { int l; asm volatile("v_mbcnt_lo_u32_b32 %0, -1, 0\n\tv_mbcnt_hi_u32_b32 %0, -1, %0" : "=v"(l)); return l; }
__device__ __forceinline__ float silu_f(float a) { return a * __builtin_amdgcn_rcpf(1.0f + __expf(-a)); }

__device__ __forceinline__ int hg_pos(int idx, int b0) { return 8 * (idx >> 2) + b0 + (idx & 3); }
struct CvtItem { const float* W; bf16* WT; const float* wk; int K, N, item; int perm; };
__device__ __forceinline__ void cvt_load(const CvtItem& d, int lane, f32x4 (&v)[8]) {
    const int nblk = d.N / 32, kb = d.item / nblk, nb = d.item % nblk, k0 = 64 * kb, n0 = 32 * nb;
#pragma unroll
    for (int i = 0; i < 8; ++i) { const int kk = i * 8 + (lane >> 3); v[i] = __builtin_nontemporal_load((const f32x4*)(d.W + (size_t)(k0 + kk) * d.N + n0 + 4 * (lane & 7))); }
}
__device__ __forceinline__ void cvt_store(const CvtItem& d, int lane, const f32x4 (&v)[8], LAS float* scr) {
    const int nblk = d.N / 32, kb = d.item / nblk, nb = d.item % nblk, k0 = 64 * kb, n0 = 32 * nb;
    const int r0 = d.perm == 1 ? (n0 < FF ? (n0 >> 7) * 256 + (n0 & 127) : ((n0 - FF) >> 7) * 256 + 128 + ((n0 - FF) & 127))
                 : d.perm == 2 ? (n0 < 2048 ? hg_pos(n0 >> 7, 0) * 256 + (n0 & 127) : (n0 < 4096 ? hg_pos((n0 - 2048) >> 7, 0) * 256 + 128 + ((n0 - 2048) & 127) : hg_pos((n0 >> 8) - 16, 4) * 256 + (n0 & 255))) : n0;
#pragma unroll
    for (int i = 0; i < 8; ++i) { const int kk = i * 8 + (lane >> 3); LAS float* dd = scr + kk * 33 + 4 * (lane & 7); dd[0] = v[i][0]; dd[1] = v[i][1]; dd[2] = v[i][2]; dd[3] = v[i][3]; }
    asm volatile("s_waitcnt lgkmcnt(0)" ::: "memory");
    const int c = lane & 7;
    f32x4 wa = {1.f, 1.f, 1.f, 1.f}, wb = {1.f, 1.f, 1.f, 1.f};
    if (d.wk) { wa = *(const f32x4*)(d.wk + k0 + 8 * c); wb = *(const f32x4*)(d.wk + k0 + 8 * c + 4); }
#pragma unroll
    for (int j = 0; j < 4; ++j) { const int n = (lane >> 3) + 8 * j; const LAS float* s = scr + (8 * c) * 33 + n;
        u32x4 o; o.x = pk_bf16(s[0 * 33] * wa[0], s[1 * 33] * wa[1]); o.y = pk_bf16(s[2 * 33] * wa[2], s[3 * 33] * wa[3]); o.z = pk_bf16(s[4 * 33] * wb[0], s[5 * 33] * wb[1]); o.w = pk_bf16(s[6 * 33] * wb[2], s[7 * 33] * wb[3]);
        *(u32x4*)(d.WT + (size_t)(r0 + n) * d.K + k0 + 8 * c) = o; }
    asm volatile("s_waitcnt lgkmcnt(0)" ::: "memory");
}
constexpr int I_IN = (D / 64) * (NIN / 32), I_OH = (D / 64) * (D / 32), I_UP = (D / 64) * (NUP / 32), I_DN = (FF / 64) * (D / 32), I_SI = (D / 64) * (NSC / 32), I_SO = I_OH;
constexpr int P0_ITEMS = I_IN + I_OH + I_UP + I_DN + I_SI + I_SO, T3_ITEMS = I_UP + I_DN;
struct CvtSrc { const float *hin, *hout, *up, *dn, *si, *so, *nffn, *nmix; unsigned char* ws; };
__device__ __forceinline__ CvtItem p0_item(const CvtSrc& s, int r) {
    if (r < I_IN) return CvtItem{s.hin, (bf16*)(s.ws + WS_WIN), nullptr, D, NIN, r, 2}; r -= I_IN;
    if (r < I_OH) return CvtItem{s.hout, (bf16*)(s.ws + WS_WOH), nullptr, D, D, r, 0}; r -= I_OH;
    if (r < I_UP) return CvtItem{s.up, (bf16*)(s.ws + WS_WUP0), s.nffn, D, NUP, r, 1}; r -= I_UP;
    if (r < I_DN) return CvtItem{s.dn, (bf16*)(s.ws + WS_WDN0), nullptr, FF, D, r, 0}; r -= I_DN;
    if (r < I_SI) return CvtItem{s.si, (bf16*)(s.ws + WS_WSI), s.nmix + D, D, NSC, r, 0}; r -= I_SI;
    return CvtItem{s.so, (bf16*)(s.ws + WS_WSO), nullptr, D, D, r, 0};
}
__device__ __forceinline__ CvtItem t3_item(const CvtSrc& s, int r) {
    if (r < I_UP) return CvtItem{s.up + (size_t)D * NUP, (bf16*)(s.ws + WS_WUP1), s.nffn + D, D, NUP, r, 1};
    return CvtItem{s.dn + (size_t)FF * D, (bf16*)(s.ws + WS_WDN1), nullptr, FF, D, r - I_UP, 0};
}
template <bool T3> __device__ __forceinline__ void cvt_run(const CvtSrc& s, int first, int stride, int nitems, LAS float* scr, int lane) {
    if (first >= nitems) return;
    f32x4 cur[8], nxt[8];
    CvtItem dc = T3 ? t3_item(s, first) : p0_item(s, first);
    cvt_load(dc, lane, cur);
    for (int it = first; it < nitems; it += stride) {
        const bool more = it + stride < nitems;
        CvtItem dn = dc;
        if (more) { dn = T3 ? t3_item(s, it + stride) : p0_item(s, it + stride); cvt_load(dn, lane, nxt); }
        cvt_store(dc, lane, cur, scr);
        if (more) {
#pragma unroll
            for (int i = 0; i < 8; ++i) cur[i] = nxt[i];
            dc = dn; }
    }
}

__device__ __forceinline__ void rms_row_bf16(const float* xrow, const float* w, bf16* orow, int lane) {
    const f32x4* xr = (const f32x4*)xrow + lane; const f32x4* wr = (const f32x4*)w + lane;
    f32x4 v[8]; float s = 0.f;
#pragma unroll
    for (int j = 0; j < 8; ++j) { v[j] = __builtin_nontemporal_load(xr + 64 * j); s += (v[j][0] * v[j][0] + v[j][1] * v[j][1]) + (v[j][2] * v[j][2] + v[j][3] * v[j][3]); }
    f32x4 gg[8];
#pragma unroll
    for (int j = 0; j < 8; ++j) gg[j] = wr[64 * j];
    const float rstd = __builtin_amdgcn_rsqf(wave_sum(s) * (1.0f / D) + EPS);
    u32x2* o8 = (u32x2*)orow + lane;
#pragma unroll
    for (int j = 0; j < 8; ++j) { const f32x4 g = gg[j]; u32x2 o; o.x = pk_bf16(v[j][0] * rstd * g[0], v[j][1] * rstd * g[1]); o.y = pk_bf16(v[j][2] * rstd * g[2], v[j][3] * rstd * g[3]); o8[64 * j] = o; }
}
__device__ __forceinline__ void rms_row_f32(const float* xrow, const float* w, float* orow, int lane) {
    const f32x4* xr = (const f32x4*)xrow + lane; const f32x4* wr = (const f32x4*)w + lane;
    f32x4 v[8]; float s = 0.f;
#pragma unroll
    for (int j = 0; j < 8; ++j) { v[j] = xr[64 * j]; s += (v[j][0] * v[j][0] + v[j][1] * v[j][1]) + (v[j][2] * v[j][2] + v[j][3] * v[j][3]); }
    const float rstd = __builtin_amdgcn_rsqf(wave_sum(s) * (1.0f / D) + EPS);
    f32x4* o = (f32x4*)orow + lane;
#pragma unroll
    for (int j = 0; j < 8; ++j) { const f32x4 g = wr[64 * j]; o[64 * j] = v[j] * rstd * g; }
}

__device__ __forceinline__ void unpack8(const u32x4 w, float (&f)[8]) { f[0] = bf_lo(w.x); f[1] = bf_hi(w.x); f[2] = bf_lo(w.y); f[3] = bf_hi(w.y); f[4] = bf_lo(w.z); f[5] = bf_hi(w.z); f[6] = bf_lo(w.w); f[7] = bf_hi(w.w); }
__device__ __forceinline__ void load8f(const float* p, float (&f)[8]) { const f32x4 a = *(const f32x4*)p, b = *(const f32x4*)(p + 4); f[0] = a[0]; f[1] = a[1]; f[2] = a[2]; f[3] = a[3]; f[4] = b[0]; f[5] = b[1]; f[6] = b[2]; f[7] = b[3]; }
template <int RS, int SEGSTRIDE> __device__ __forceinline__ void conv_glu_phase(const bf16* U, const float* cw  , bf16* ACT, int gtid, int gthreads) {
    constexpr int NCG = FF / 8, NSEG = M / SEGSTRIDE;
    for (int it = gtid; it < NCG * NSEG; it += gthreads) {
        const int jg = it % NCG, seg = it / NCG, c0 = jg * 8, t0 = seg * SEGSTRIDE;
        const bool first = (t0 & (SEQ - 1)) == 0;
        u32x4 rg[RS + 2], rv[RS + 2];
        const bf16* up = U + (size_t)(first ? t0 : t0 - 2) * NUP + c0;
#pragma unroll
        for (int r = 0; r < RS + 2; ++r) { const size_t o = (size_t)(first ? (r < 2 ? 0 : r - 2) : r) * NUP; rg[r] = *(const u32x4*)(up + o); rv[r] = *(const u32x4*)(up + o + FF); }
        float wg[3][8], wv[3][8];
#pragma unroll
        for (int k = 0; k < 3; ++k) { load8f(cw + k * NUP + c0, wg[k]); load8f(cw + k * NUP + FF + c0, wv[k]); }
        float g2[8], g1[8], v2[8], v1[8];
        unpack8(rg[0], g2); unpack8(rg[1], g1); unpack8(rv[0], v2); unpack8(rv[1], v1);
        if (first) {
#pragma unroll
            for (int j = 0; j < 8; ++j) { g2[j] = 0.f; g1[j] = 0.f; v2[j] = 0.f; v1[j] = 0.f; }
        }
#pragma unroll
        for (int r = 0; r < RS; ++r) {
            float g0[8], v0[8];
            unpack8(rg[r + 2], g0); unpack8(rv[r + 2], v0);
            float o[8];
#pragma unroll
            for (int j = 0; j < 8; ++j) { const float cgv = wg[0][j] * g2[j] + wg[1][j] * g1[j] + wg[2][j] * g0[j]; const float cvv = wv[0][j] * v2[j] + wv[1][j] * v1[j] + wv[2][j] * v0[j];
                o[j] = silu_f(cgv) * cvv; g2[j] = g1[j]; g1[j] = g0[j]; v2[j] = v1[j]; v1[j] = v0[j]; }
            u32x4 w; w.x = pk_bf16(o[0], o[1]); w.y = pk_bf16(o[2], o[3]); w.z = pk_bf16(o[4], o[5]); w.w = pk_bf16(o[6], o[7]);
            *(u32x4*)(ACT + (size_t)(t0 + r) * FF + c0) = w;
        }
    }
}
__device__ __forceinline__ void short_conv_phase(const bf16* P2, const float* cw  , bf16* Y, int gtid, int gthreads) {
    constexpr int NCG = D / 8, RS = 8, NSEG = M / RS;
    for (int it = gtid; it < NCG * NSEG; it += gthreads) {
        const int jg = it % NCG, seg = it / NCG, c0 = jg * 8, t0 = seg * RS;
        const bool first = (t0 & (SEQ - 1)) == 0;
        u32x4 rc[RS + 2], rh[RS + 2];
        const bf16* pp = P2 + (size_t)(first ? t0 : t0 - 2) * NSC + c0;
#pragma unroll
        for (int r = 0; r < RS + 2; ++r) { const size_t o = (size_t)(first ? (r < 2 ? 0 : r - 2) : r) * NSC; rc[r] = *(const u32x4*)(pp + o + D); rh[r] = *(const u32x4*)(pp + o + 2 * D); }
        u32x4 rb[RS];
#pragma unroll
        for (int r = 0; r < 4; ++r) rb[r] = *(const u32x4*)(P2 + (size_t)(t0 + r) * NSC + c0);
        float w3[3][8];
#pragma unroll
        for (int k = 0; k < 3; ++k) load8f(cw + k * D + c0, w3[k]);
        float z2[8], z1[8];
        { float a[8], b[8]; unpack8(rc[0], a); unpack8(rh[0], b);
#pragma unroll
          for (int j = 0; j < 8; ++j) z2[j] = first ? 0.f : a[j] * b[j];
          unpack8(rc[1], a); unpack8(rh[1], b);
#pragma unroll
          for (int j = 0; j < 8; ++j) z1[j] = first ? 0.f : a[j] * b[j]; }
#pragma unroll
        for (int r = 0; r < RS; ++r) {
            float gb[8], a[8], b[8], o[8];
            if (r == 2) {
#pragma unroll
                for (int q = 4; q < RS; ++q) rb[q] = *(const u32x4*)(P2 + (size_t)(t0 + q) * NSC + c0); }
            unpack8(rb[r], gb); unpack8(rc[r + 2], a); unpack8(rh[r + 2], b);
#pragma unroll
            for (int j = 0; j < 8; ++j) { const float z0 = a[j] * b[j]; o[j] = gb[j] * (w3[0][j] * z2[j] + w3[1][j] * z1[j] + w3[2][j] * z0); z2[j] = z1[j]; z1[j] = z0; }
            u32x4 w; w.x = pk_bf16(o[0], o[1]); w.y = pk_bf16(o[2], o[3]); w.z = pk_bf16(o[4], o[5]); w.w = pk_bf16(o[6], o[7]);
            *(u32x4*)(Y + (size_t)(t0 + r) * D + c0) = w;
        }
    }
}

__device__ __forceinline__ f32x4 mma_t(const bf16x8 a, const bf16x8 b, const f32x4 c) { return __builtin_amdgcn_mfma_f32_16x16x32_bf16(b, a, c, 0, 0, 0); }
constexpr int KT_LD = 72;
constexpr int R1_KET = 0, R1_VT = R1_KET + 128 * KT_LD * 2, R1_AM = R1_VT + 128 * KT_LD * 2, R1_END = R1_AM + 64 * KT_LD * 2;
static_assert(R1_END <= 131072, "R1 LDS");

__device__ __forceinline__ void r1_phase(unsigned char* lds, const bf16* QE, const bf16* KE, const bf16* V, bf16* OINTRA, bf16* UT, int nblk, int blk, const int wid, const int lane) {
    const int tid = wid * 64 + lane, fr = lane & 15, fq = lane >> 4;
    bf16* sKET = (bf16*)(lds + R1_KET); bf16* sVT = (bf16*)(lds + R1_VT); bf16* sAM = (bf16*)(lds + R1_AM);
    const int seg = tid >> 7, d = tid & 127;
    unsigned short kn[16], vn[16];
    if (blk < NTASK) { const int bh = blk >> 6, c = blk & 63, b_ = bh >> 4, h = bh & 15, m0 = b_ * SEQ + c * 64; const size_t gb = (size_t)(m0 + seg * 16) * D + h * HD + d;
#pragma unroll
        for (int i = 0; i < 16; ++i) { kn[i] = KE[gb + (size_t)i * D]; vn[i] = V[gb + (size_t)i * D]; } }
    for (int task = blk; task < NTASK; task += nblk) {
        const int bh = task >> 6, c = task & 63, b_ = bh >> 4, h = bh & 15, m0 = b_ * SEQ + c * 64;
        bf16x8 fa[2][4], fb[2][4];
#pragma unroll
        for (int q = 0; q < 2; ++q) { const int id = wid * 2 + q, ti = id >> 2, sj = id & 3;
            if (sj <= ti) {
#pragma unroll
                for (int kk = 0; kk < 4; ++kk) { fa[q][kk] = *(const bf16x8*)(QE + (size_t)(m0 + ti * 16 + fr) * D + h * HD + kk * 32 + fq * 8); fb[q][kk] = *(const bf16x8*)(KE + (size_t)(m0 + sj * 16 + fr) * D + h * HD + kk * 32 + fq * 8); } } }
        { u32x4 w0, w1;
          w0.x = kn[0] | ((unsigned)kn[1] << 16); w0.y = kn[2] | ((unsigned)kn[3] << 16); w0.z = kn[4] | ((unsigned)kn[5] << 16); w0.w = kn[6] | ((unsigned)kn[7] << 16);
          w1.x = kn[8] | ((unsigned)kn[9] << 16); w1.y = kn[10] | ((unsigned)kn[11] << 16); w1.z = kn[12] | ((unsigned)kn[13] << 16); w1.w = kn[14] | ((unsigned)kn[15] << 16);
          *(u32x4*)(sKET + d * KT_LD + seg * 16) = w0; *(u32x4*)(sKET + d * KT_LD + seg * 16 + 8) = w1;
          w0.x = vn[0] | ((unsigned)vn[1] << 16); w0.y = vn[2] | ((unsigned)vn[3] << 16); w0.z = vn[4] | ((unsigned)vn[5] << 16); w0.w = vn[6] | ((unsigned)vn[7] << 16);
          w1.x = vn[8] | ((unsigned)vn[9] << 16); w1.y = vn[10] | ((unsigned)vn[11] << 16); w1.z = vn[12] | ((unsigned)vn[13] << 16); w1.w = vn[14] | ((unsigned)vn[15] << 16);
          *(u32x4*)(sVT + d * KT_LD + seg * 16) = w0; *(u32x4*)(sVT + d * KT_LD + seg * 16 + 8) = w1; }
        if (task + nblk < NTASK) { const int tn = task + nblk, bhn = tn >> 6, cn = tn & 63, bn = bhn >> 4, hn = bhn & 15, m0n = bn * SEQ + cn * 64; const size_t gb = (size_t)(m0n + seg * 16) * D + hn * HD + d;
#pragma unroll
            for (int i = 0; i < 16; ++i) { kn[i] = KE[gb + (size_t)i * D]; vn[i] = V[gb + (size_t)i * D]; } }
#pragma unroll
        for (int q = 0; q < 2; ++q) { const int id = wid * 2 + q, ti = id >> 2, sj = id & 3; f32x4 acc = {0.f, 0.f, 0.f, 0.f};
            if (sj <= ti) {
#pragma unroll
                for (int kk = 0; kk < 4; ++kk) acc = mma_t(fa[q][kk], fb[q][kk], acc);
                const int t = ti * 16 + fr, s0 = sj * 16 + 4 * fq;
#pragma unroll
                for (int j = 0; j < 4; ++j) if (s0 + j > t) acc[j] = 0.f;
            }
            u32x2 w; w.x = pk_bf16(acc[0], acc[1]); w.y = pk_bf16(acc[2], acc[3]);
            *(u32x2*)(sAM + (ti * 16 + fr) * KT_LD + sj * 16 + 4 * fq) = w; }
        __syncthreads();
        { const bf16x8 a0 = *(const bf16x8*)(sVT + (wid * 16 + fr) * KT_LD + fq * 8), a1 = *(const bf16x8*)(sVT + (wid * 16 + fr) * KT_LD + 32 + fq * 8);
          bf16* up = UT + (size_t)task * 16384 + (size_t)(wid * 16 + fr) * 128 + 4 * fq;
#pragma unroll
          for (int dj = 0; dj < 8; ++dj) { const bf16x8 b0 = *(const bf16x8*)(sKET + (dj * 16 + fr) * KT_LD + fq * 8), b1 = *(const bf16x8*)(sKET + (dj * 16 + fr) * KT_LD + 32 + fq * 8);
              f32x4 acc = {0.f, 0.f, 0.f, 0.f}; acc = mma_t(a0, b0, acc); acc = mma_t(a1, b1, acc); u32x2 w; w.x = pk_bf16(acc[0], acc[1]); w.y = pk_bf16(acc[2], acc[3]); *(u32x2*)(up + dj * 16) = w; } }
        { const int ti = wid >> 1; const bf16x8 a0 = *(const bf16x8*)(sAM + (ti * 16 + fr) * KT_LD + fq * 8), a1 = *(const bf16x8*)(sAM + (ti * 16 + fr) * KT_LD + 32 + fq * 8);
          bf16* op = OINTRA + (size_t)(m0 + ti * 16 + fr) * D + h * HD + 4 * fq;
#pragma unroll
          for (int q = 0; q < 4; ++q) { const int vj = (wid & 1) * 4 + q; const bf16x8 b0 = *(const bf16x8*)(sVT + (vj * 16 + fr) * KT_LD + fq * 8), b1 = *(const bf16x8*)(sVT + (vj * 16 + fr) * KT_LD + 32 + fq * 8);
              f32x4 acc = {0.f, 0.f, 0.f, 0.f}; acc = mma_t(a0, b0, acc); acc = mma_t(a1, b1, acc); u32x2 w; w.x = pk_bf16(acc[0], acc[1]); w.y = pk_bf16(acc[2], acc[3]); *(u32x2*)(op + vj * 16) = w; } }
        __syncthreads();
    }
}
__device__ __forceinline__ void r2_phase(const bf16* UT, const float* VEC, bf16* SP, int gtid, int gthreads) {
    for (int e = gtid; e < 32 * 4096; e += gthreads) {
        const int bh = e >> 12, rem = e & 4095, d4 = (rem & 31) * 4;
        f32x4 S = {0.f, 0.f, 0.f, 0.f};
        for (int c0 = 0; c0 < 64; c0 += 8) {
            u32x2 uw[8]; f32x4 er[8], ebr[8], dc[8];
#pragma unroll
            for (int i = 0; i < 8; ++i) { const size_t task = (size_t)bh * 64 + c0 + i;
                uw[i] = *(const u32x2*)(UT + task * 16384 + (size_t)rem * 4);
                er[i] = *(const f32x4*)(VEC + task * 128 + d4); ebr[i] = *(const f32x4*)(VEC + 2048 * 128 + task * 128 + d4); dc[i] = *(const f32x4*)(VEC + 2 * 2048 * 128 + task * 128 + d4); }
#pragma unroll
            for (int i = 0; i < 8; ++i) { const size_t task = (size_t)bh * 64 + c0 + i;
                const f32x4 Sp = S * er[i];
                u32x2 w; w.x = pk_bf16(Sp[0], Sp[1]); w.y = pk_bf16(Sp[2], Sp[3]); *(u32x2*)(SP + task * 16384 + (size_t)rem * 4) = w;
                const f32x4 u = {bf_lo(uw[i].x), bf_hi(uw[i].x), bf_lo(uw[i].y), bf_hi(uw[i].y)};
                S = dc[i] * S + ebr[i] * u; }
        }
    }
}
struct R3Set { bf16x8 a[4]; bf16x8 b[4][4]; u32x2 oi[4]; u32x2 g[4]; f32x4 gn[4]; };
__device__ __forceinline__ void r3_load(R3Set& s, int un, const bf16* QE2, const bf16* SP, const bf16* OINTRA, const bf16* G, const float* gain, int fr, int fq) {
    const int task = un >> 3, ti = (un >> 1) & 3, half = un & 1, bh = task >> 6, c = task & 63, b_ = bh >> 4, h = bh & 15, row = b_ * SEQ + c * 64 + ti * 16 + fr;
    const bf16* ap = QE2 + (size_t)row * D + h * HD + fq * 8;
#pragma unroll
    for (int kk = 0; kk < 4; ++kk) s.a[kk] = *(const bf16x8*)(ap + kk * 32);
    const bf16* sp = SP + (size_t)task * 16384 + (size_t)(half * 64 + fr) * 128 + fq * 8; const size_t obase = (size_t)row * D + h * HD + half * 64 + 4 * fq;
#pragma unroll
    for (int q = 0; q < 4; ++q) { s.oi[q] = *(const u32x2*)(OINTRA + obase + q * 16); s.g[q] = *(const u32x2*)(G + obase + q * 16); s.gn[q] = *(const f32x4*)(gain + h * HD + half * 64 + q * 16 + 4 * fq);
#pragma unroll
        for (int kk = 0; kk < 4; ++kk) s.b[q][kk] = *(const bf16x8*)(sp + (size_t)q * 16 * 128 + kk * 32); }
}
__device__ __forceinline__ void r3_phase(const bf16* QE2, const bf16* SP, const bf16* OINTRA, const bf16* G, const float* gain, bf16* OG, float* SSO, int gw, int ngw, int lane) {
    const int fr = lane & 15, fq = lane >> 4;
    R3Set cur, nxt;
    if (gw < NTASK * 8) r3_load(cur, gw, QE2, SP, OINTRA, G, gain, fr, fq);
    for (int un = gw; un < NTASK * 8; un += ngw) {
        const bool more = un + ngw < NTASK * 8;
        if (more) r3_load(nxt, un + ngw, QE2, SP, OINTRA, G, gain, fr, fq);
        const int task = un >> 3, ti = (un >> 1) & 3, half = un & 1, bh = task >> 6, c = task & 63, b_ = bh >> 4, h = bh & 15, row = b_ * SEQ + c * 64 + ti * 16 + fr;
        const size_t obase = (size_t)row * D + h * HD + half * 64 + 4 * fq;
        float ssum = 0.f;
#pragma unroll
        for (int q = 0; q < 4; ++q) { f32x4 acc = {bf_lo(cur.oi[q].x), bf_hi(cur.oi[q].x), bf_lo(cur.oi[q].y), bf_hi(cur.oi[q].y)};
            const f32x4 gn = cur.gn[q];
#pragma unroll
            for (int kk = 0; kk < 4; ++kk) acc = mma_t(cur.a[kk], cur.b[q][kk], acc);
            ssum += (acc[0] * acc[0] + acc[1] * acc[1]) + (acc[2] * acc[2] + acc[3] * acc[3]);
            u32x2 w; w.x = pk_bf16(acc[0] * gn[0] * bf_lo(cur.g[q].x), acc[1] * gn[1] * bf_hi(cur.g[q].x)); w.y = pk_bf16(acc[2] * gn[2] * bf_lo(cur.g[q].y), acc[3] * gn[3] * bf_hi(cur.g[q].y));
            *(u32x2*)(OG + obase + q * 16) = w; }
        ssum += __shfl_xor(ssum, 16); ssum += __shfl_xor(ssum, 32);
        if (fq == 0) unsafeAtomicAdd(SSO + row, ssum);
        if (more) cur = nxt;
    }
}

#define XB_TMO      128
#define XB_XCNT(j)  (256  + 64 * (j))
#define XB_XSUB(j)  (1280 + 64 * (j))
#define XB_XGEN(j)  (2304 + 64 * (j))
#define XB_TOP      3328
#define XB_TOPGEN   3392
#define XCD_BAR_WORDS 3456
#define XB_SPIN_CAP (1u << 20)
__device__ __forceinline__ unsigned xb_ld(unsigned* p)              { return __hip_atomic_load(p, __ATOMIC_RELAXED, __HIP_MEMORY_SCOPE_AGENT); }
__device__ __forceinline__ unsigned xb_add(unsigned* p, unsigned v) { return __hip_atomic_fetch_add(p, v, __ATOMIC_RELAXED, __HIP_MEMORY_SCOPE_AGENT); }
__device__ __forceinline__ unsigned xb_xcc_id() { return (unsigned)__builtin_amdgcn_s_getreg((3 << 11) | 20) & 0xFu; }
#define XB_SPIN(cond, bar) do { unsigned _sp = 0; while (cond) { __builtin_amdgcn_s_sleep(1); \
    if ((++_sp & 255u) == 0u) { if (xb_ld(&(bar)[XB_TMO])) break; if (_sp > XB_SPIN_CAP) { atomicAdd(&(bar)[XB_TMO], 1u); break; } } } } while (0)
__device__ __forceinline__ void xcd_barrier_complete(unsigned* bar, unsigned x, unsigned G, unsigned& nloc, unsigned& nx) {
    unsigned sum, cnt, mine, sp = 0u;
    for (;;) {
        sum = 0u; cnt = 0u; mine = 0u;
#pragma unroll
        for (unsigned j = 0; j < 16; ++j) { const unsigned c = xb_ld(&bar[XB_XCNT(j)]); sum += c; cnt += (c > 0u) ? 1u : 0u; mine = (j == x) ? c : mine; }
        if (sum == G) break;
        __builtin_amdgcn_s_sleep(1);
        if ((++sp & 255u) == 0u) { if (xb_ld(&bar[XB_TMO])) break; if (sp > XB_SPIN_CAP) { atomicAdd(&bar[XB_TMO], 1u); break; } }
    }
    nloc = mine > 0u ? mine : 1u; nx = cnt > 0u ? cnt : 1u;
}
__device__ __forceinline__ void xcd_barrier(unsigned* bar, volatile LAS unsigned* st, int wave, unsigned G) {
    asm volatile("s_waitcnt vmcnt(0)" ::: "memory");
    __syncthreads();
    if (wave == 0 && lane_id() == 0) {
        const unsigned x = xb_xcc_id();
        __builtin_amdgcn_s_waitcnt(0);
        unsigned nloc = st[0], nx = st[1];
        if (nloc == 0u) { xcd_barrier_complete(bar, x, G, nloc, nx); st[0] = nloc; st[1] = nx; }
        const unsigned old = xb_add(&bar[XB_XSUB(x)], 1u);
        const unsigned gen = old / nloc;
        if (old + 1u == (gen + 1u) * nloc) {
            __builtin_amdgcn_fence(__ATOMIC_RELEASE, "agent");
            asm volatile("s_waitcnt vmcnt(0)" ::: "memory");
            const unsigned og = xb_add(&bar[XB_TOP], 1u);
            const unsigned tg = og / nx;
            if (og + 1u == (tg + 1u) * nx) xb_add(&bar[XB_TOPGEN], 1u);
            else XB_SPIN(xb_ld(&bar[XB_TOPGEN]) == tg, bar);
            __builtin_amdgcn_fence(__ATOMIC_ACQUIRE, "agent");
            xb_add(&bar[XB_XGEN(x)], 1u);
            asm volatile("s_waitcnt vmcnt(0)" ::: "memory");
        } else {
            XB_SPIN(xb_ld(&bar[XB_XGEN(x)]) == gen, bar);
            __builtin_amdgcn_fence(__ATOMIC_ACQUIRE, "agent");
            asm volatile("s_waitcnt vmcnt(0)" ::: "memory");
        }
    }
    __syncthreads();
}

enum { PH_P0 = 0, PH_G1, PH_R1, PH_R2, PH_R3, PH_G2, PH_N1, PH_G3, PH_C1, PH_G4, PH_N2, PH_G5, PH_C2, PH_G6, PH_N3, PH_G7, PH_C3, PH_G8, PH_FN, NPH };
struct Args { const float* in[14]; float* out; unsigned char* ws; int ph_lo, ph_hi; };

__global__ void __launch_bounds__(NTHR, 2) trunk_fwd(Args args) {
    extern __shared__ __attribute__((aligned(16))) unsigned char lds[];
    const int wave = __builtin_amdgcn_readfirstlane(threadIdx.x >> 6);
    const int G_ = gridDim.x, blk = blockIdx.x, ngw = G_ * NWAVES, gthreads = G_ * NTHR;
#define LANE_SETUP() int lane = lane_id(); asm volatile("" : "+v"(lane)); const int tid = wave * 64 + lane, gw = blk * NWAVES + wave, gtid = blk * NTHR + tid; (void)tid; (void)gw; (void)gtid
    unsigned char* ws = args.ws;
    float* H = args.out;
    bf16* XN = (bf16*)(ws + WS_XN);
    const int lo = args.ph_lo, hi = args.ph_hi;
#define IN(k) (lo <= (k) && (k) < hi)
    if (lo < 0) cg::this_grid().sync();
    volatile LAS unsigned* bst = (volatile LAS unsigned*)((LAS unsigned char*)lds + 131072 + 1024);
    unsigned* bar = (unsigned*)ws;
    {
        if (wave == 0) { const int l0 = lane_id(); if (l0 < 2) bst[l0] = 0u; if (l0 == 0) (void)xb_add(&bar[XB_XCNT(xb_xcc_id())], 1u); }
        __syncthreads();
    }
#define SEAM(k) do { xcd_barrier(bar, bst, wave, (unsigned)G_); } while (0)
#define RUN_GEMM(MODE, KC, Aptr, Bptr, NN, SETUP) do { pg8::Gemm g{(const bf16*)(Aptr), (const bf16*)(Bptr), M, (NN), (KC)}; pg8::Epi<MODE, KC> E{}; SETUP; \
        pg8::StaticOrder S; S.init(M, (NN), G_, blk); pg8::gemm_phase<pg8::Epi<MODE, KC>, pg8::StaticOrder, true, true>((LAS unsigned char*)lds, g, S, E, wave); } while (0)
    { LANE_SETUP();
        LAS float* scr = (LAS float*)((LAS unsigned char*)lds + wave * 16384);
        { const CvtSrc cs{args.in[3], args.in[6], args.in[10], args.in[12], args.in[7], args.in[9], args.in[2], args.in[1], ws};
          cvt_run<false>(cs, gw, ngw, P0_ITEMS, scr, lane); }
        for (int m = gw; m < M; m += ngw) rms_row_bf16(args.in[0] + (size_t)m * D, args.in[1], XN + (size_t)m * D, lane);
        for (int i = gtid; i < 5 * M; i += gthreads) ((float*)(ws + WS_SSP))[i] = 0.f;
        SEAM(PH_P0);
    }
#pragma nounroll
    for (int L = 0; L < 2; ++L) {
        if (L == 0) {
            RUN_GEMM(4, 2048, XN, ws + WS_WIN, NIN, (E.Q = (bf16*)(ws + WS_Q), E.KE = (bf16*)(ws + WS_LOGF), E.LOGF = (float*)(ws + WS_LOGF + 32 * MiB), E.V = (bf16*)(ws + WS_V), E.G = (bf16*)(ws + WS_G), E.lbt = args.in[4]));
            SEAM(PH_G1);
            { LANE_SETUP();
              r1_phase(lds, (const bf16*)(ws + WS_Q), (const bf16*)(ws + WS_LOGF), (const bf16*)(ws + WS_V), (bf16*)(ws + WS_OI), (bf16*)(ws + WS_UT), G_, blk, wave, lane); }
            SEAM(PH_R1);
            { LANE_SETUP();
              r2_phase((const bf16*)(ws + WS_UT), (const float*)(ws + WS_LOGF + 32 * MiB), (bf16*)(ws + WS_SP), gtid, gthreads); }
            SEAM(PH_R2);
            { LANE_SETUP();
              r3_phase((const bf16*)(ws + WS_Q), (const bf16*)(ws + WS_SP), (const bf16*)(ws + WS_OI), (const bf16*)(ws + WS_G), args.in[5], (bf16*)(ws + WS_V), (float*)(ws + WS_SSP) + 3 * M, gw, ngw, lane); }
            SEAM(PH_R3);
        } else {
            RUN_GEMM(0, 2048, XN, ws + WS_WSI, NSC, (E.O = (bf16*)(ws + WS_P2), E.ldc = NSC, E.ssp_in = (const float*)(ws + WS_SSP) + 1 * M));
            SEAM(PH_G5);
            { LANE_SETUP();
              short_conv_phase((const bf16*)(ws + WS_P2), args.in[8], (bf16*)(ws + WS_Y), gtid, gthreads); }
            SEAM(PH_C2);
        }
        RUN_GEMM(1, 2048, ws + (L ? WS_Y : WS_V), ws + (L ? WS_WSO : WS_WOH), D, (E.out = nullptr, E.res = args.in[0], E.resb = L ? (const bf16*)XN : (const bf16*)nullptr, E.ss = L ? (const float*)nullptr : (const float*)(ws + WS_SSP) + 3 * M, E.hb = XN, E.ssp_out = (float*)(ws + WS_SSP) + (L ? 2 * M : 0)));
        SEAM(PH_G2);
        RUN_GEMM(3, 2048, XN, ws + (L ? WS_WUP1 : WS_WUP0), NUP, (E.O = (bf16*)(ws + WS_ACT), E.Ub = (bf16*)(ws + WS_U), E.cw = args.in[11] + (L ? 3 * NUP : 0), E.ssp_in = (const float*)(ws + WS_SSP) + (L ? 2 * M : 0)));
        if (L == 0) {
            const int nrem = ((NUP / 256) * (M / 256)) % G_, first_idle = nrem, nconv = G_ - first_idle;
            if (blk >= first_idle) { LANE_SETUP();
                LAS float* scr = (LAS float*)((LAS unsigned char*)lds + wave * 16384);
                const CvtSrc cs{args.in[3], args.in[6], args.in[10], args.in[12], args.in[7], args.in[9], args.in[2], args.in[1], ws};
                cvt_run<true>(cs, (blk - first_idle) * NWAVES + wave, nconv * NWAVES, T3_ITEMS, scr, lane); }
        }
        SEAM(PH_G3);
        { LANE_SETUP();
          conv_glu_phase<2, 64>((const bf16*)(ws + WS_U), args.in[11] + (L ? 3 * NUP : 0), (bf16*)(ws + WS_ACT), gtid, gthreads); }
        SEAM(PH_C1);
        RUN_GEMM(1, 5632, ws + WS_ACT, ws + (L ? WS_WDN1 : WS_WDN0), D, (E.out = nullptr, E.res = nullptr, E.resb = XN, E.ss = nullptr, E.hb = XN, E.ssp_out = (float*)(ws + WS_SSP) + (L ? 4 * M : 1 * M)));
        SEAM(PH_G4);
    }
    { LANE_SETUP();
        const float* ssq = (const float*)(ws + WS_SSP) + 4 * M; const f32x4* wr = (const f32x4*)args.in[13];
        constexpr int NIT = M * (D / 8);
        for (int it0 = gtid; it0 < NIT; it0 += 4 * gthreads) {
            u32x4 hw[4]; float sq[4]; const int c8 = (it0 & 255) * 8; const f32x4 g0 = wr[c8 >> 2], g1 = wr[(c8 >> 2) + 1];
#pragma unroll
            for (int k = 0; k < 4; ++k) { const int it = it0 + k * gthreads; if (it < NIT) { const int row = it >> 8; hw[k] = __builtin_nontemporal_load((const u32x4*)(XN + (size_t)row * D + c8)); sq[k] = ssq[row]; } }
#pragma unroll
            for (int k = 0; k < 4; ++k) { const int it = it0 + k * gthreads; if (it < NIT) { const int row = it >> 8;
                const float rstd = __builtin_amdgcn_rsqf(sq[k] * (1.0f / D) + EPS);
                f32x4 o0 = {bf_lo(hw[k].x), bf_hi(hw[k].x), bf_lo(hw[k].y), bf_hi(hw[k].y)}, o1 = {bf_lo(hw[k].z), bf_hi(hw[k].z), bf_lo(hw[k].w), bf_hi(hw[k].w)};
                o0 = o0 * rstd * g0; o1 = o1 * rstd * g1;
                f32x4* op = (f32x4*)(H + (size_t)row * D + c8); __builtin_nontemporal_store(o0, op); __builtin_nontemporal_store(o1, op + 1); } }
        }
    }
#undef IN
#undef LANE_SETUP
#undef SEAM
#undef RUN_GEMM
}

extern "C" void kernel_launch(void* const* d_in, const int* in_sizes, int n_in, void* d_out, int out_size, void* d_ws, size_t ws_size, hipStream_t stream) {
    static int grid = 0;
    if (grid == 0) {
        if (n_in != 14 || in_sizes[0] != M * D || out_size != M * D || ws_size < WS_END) { fprintf(stderr, "kernel_launch: unexpected shapes (n_in %d, in0 %d, out %d, ws %zu < %zu)\n", n_in, n_in > 0 ? in_sizes[0] : -1, out_size, ws_size, (size_t)WS_END); grid = -1; return; }
        int dev = 0, cus = 0, per_cu = 0;
        if (hipGetDevice(&dev) != hipSuccess || hipDeviceGetAttribute(&cus, hipDeviceAttributeMultiprocessorCount, dev) != hipSuccess) { grid = -1; return; }
        if (hipFuncSetAttribute((const void*)trunk_fwd, hipFuncAttributeMaxDynamicSharedMemorySize, LDS_BYTES) != hipSuccess) { fprintf(stderr, "kernel_launch: hipFuncSetAttribute failed\n"); grid = -1; return; }
        if (hipOccupancyMaxActiveBlocksPerMultiprocessor(&per_cu, (const void*)trunk_fwd, NTHR, LDS_BYTES) != hipSuccess || per_cu < 1) { fprintf(stderr, "kernel_launch: occupancy query says %d\n", per_cu); per_cu = 1; }
        (void)hipGetLastError();
        grid = cus * 1;
    }
    if (grid < 0) return;
    if (hipMemsetAsync(d_ws, 0, 16384, stream) != hipSuccess) { fprintf(stderr, "kernel_launch: memset failed\n"); return; }
    Args a{};
    for (int i = 0; i < 14; ++i) a.in[i] = (const float*)d_in[i];
    a.out = (float*)d_out; a.ws = (unsigned char*)d_ws;
#if MK_SINGLE
    a.ph_lo = 0; a.ph_hi = NPH;
    void* kargs[] = {&a};
    hipError_t e = hipLaunchCooperativeKernel((const void*)trunk_fwd, dim3(grid), dim3(NTHR), kargs, LDS_BYTES, stream);
    if (e != hipSuccess) fprintf(stderr, "kernel_launch: cooperative launch failed: %s (grid %d)\n", hipGetErrorString(e), grid);
#else
    for (int p = 0; p < NPH; ++p) { a.ph_lo = p; a.ph_hi = p + 1; hipLaunchKernelGGL(trunk_fwd, dim3(grid), dim3(NTHR), LDS_BYTES, stream, a); }
#endif
}
```

```cpp
#include <hip/hip_runtime.h>
#include <hip/hip_cooperative_groups.h>
#include <cstdio>
#include <cstdint>
namespace cg = cooperative_groups;
#ifndef MK_SINGLE
#define MK_SINGLE 1
#endif
namespace pg8 {
#define PG8_LAS __attribute__((address_space(3)))
typedef unsigned short bf16_t;
typedef short bf16x8 __attribute__((ext_vector_type(8)));
typedef float f32x4 __attribute__((ext_vector_type(4)));
typedef unsigned u32x4 __attribute__((ext_vector_type(4)));
constexpr int BM = 256, BK = 64, HALF = 128, HTB = HALF * BK * 2  , STAGE_BYTES = 8 * HTB, NXCD = 8, WGM = 8;

__host__ __device__ __forceinline__ int lds_byte(int r, int c) { const int st = (r >> 4) * 2 + (c >> 5), rr = r & 15, cc = c & 31, ob = rr * 64 + cc * 2; return st * 1024 + (ob ^ (((ob >> 9) & 1) << 5)); }
__host__ __device__ __forceinline__ void stage_rc(int b, int& R, int& C) { const int st = b / 1024, sb = b % 1024, swz = sb ^ (((sb >> 9) & 1) << 5); R = (st >> 1) * 16 + swz / 64; C = (st & 1) * 32 + (swz % 64) / 2; }
__host__ __device__ __forceinline__ int perm32(int rho) { const int n = rho >> 4, i = rho & 15; return 8 * (i >> 2) + 4 * n + (i & 3); }

struct Unit { int pm, pn; };
struct Gemm { const bf16_t* A; const bf16_t* Bt; int M, N, K; };

struct StaticOrder {
    int nM, nN, nwg, G, c;
    __host__ __device__ void init(int M, int N, int G_, int c_) { nM = M / BM; nN = N / BM; nwg = nM * nN; G = G_; c = c_; }
    __host__ __device__ bool next(int i, Unit& u) const {
        const long L = (long)i * G + c; if (L >= nwg) return false;
        int wgid = (int)L; { const int q = nwg / NXCD, r = nwg % NXCD, xcd = wgid % NXCD, off = wgid / NXCD; wgid = (xcd < r ? xcd * (q + 1) : r * (q + 1) + (xcd - r) * q) + off; }
        const int nig = WGM * nN, gid = wgid / nig, fm = gid * WGM, gsz = (nM - fm) < WGM ? (nM - fm) : WGM;
        u.pm = fm + ((wgid % nig) % gsz); u.pn = (wgid % nig) / gsz; return true;
    }
    __device__ __forceinline__ void a_ready(const Unit&) const {}
    __device__ __forceinline__ void done(const Unit&) const {}
};
__device__ __forceinline__ unsigned cvt_pk_bf16(float lo, float hi) { unsigned r; asm volatile("v_cvt_pk_bf16_f32 %0, %1, %2" : "=v"(r) : "v"(lo), "v"(hi)); return r; }
typedef float f32x2 __attribute__((ext_vector_type(2)));
typedef unsigned u32x2 __attribute__((ext_vector_type(2)));
__device__ __forceinline__ float ror1(float v) { return __int_as_float(__builtin_amdgcn_update_dpp(0, __float_as_int(v), 0x121, 0xf, 0xf, true)); }
__device__ __forceinline__ float ror2(float v) { return __int_as_float(__builtin_amdgcn_update_dpp(0, __float_as_int(v), 0x122, 0xf, 0xf, true)); }
template <int K_> __device__ __forceinline__ float shr_dpp(float v) { return __int_as_float(__builtin_amdgcn_update_dpp(0, __float_as_int(v), 0x110 + K_, 0xf, 0xf, true)); }
__device__ __forceinline__ float bc15_dpp(float v) { return __int_as_float(__builtin_amdgcn_update_dpp(0, __float_as_int(v), 0x15F, 0xf, 0xf, false)); }
template <int K_> __device__ __forceinline__ float shr_keep(float old, float v) { return __int_as_float(__builtin_amdgcn_update_dpp(__float_as_int(old), __float_as_int(v), 0x110 + K_, 0xf, 0xf, false)); }
template <int mode, int KC_> struct Epi {
    static constexpr bool PERM = true, AFTER_DRAIN = false; static constexpr int KC = KC_;
    bf16_t* O; int ldc; const float* ssp_in;
    bf16_t* Ub; const float* cw;
    bf16_t* hb; float* ssp_out;
    const bf16_t* resb;
    float* out; const float* res; const float* ss;
    bf16_t* Q; float* LOGF; bf16_t* V; bf16_t* G; const float* lbt;
    bf16_t* KE;
    __device__ __forceinline__ void operator()(const f32x4 (&acc)[2][2][4][2], const Unit& u, int wr, int wc, int fr_, int fq_) const {
        int l_; asm volatile("v_mbcnt_lo_u32_b32 %0, -1, 0\n\tv_mbcnt_hi_u32_b32 %0, -1, %0" : "=v"(l_));
        const int fr = l_ & 15, fq = l_ >> 4; (void)fr_; (void)fq_;
        const int row0 = u.pm * BM + wr * 64 + fr;
        if constexpr (mode == 0) {
            const int col0 = u.pn * BM + wc * 32 + 8 * fq;
            float rs[2][4];
#pragma unroll
            for (int ai = 0; ai < 2; ++ai)
#pragma unroll
                for (int m = 0; m < 4; ++m) rs[ai][m] = ssp_in ? ssp_in[row0 + ai * HALF + m * 16] : 1.0f;
            if (ssp_in) {
#pragma unroll
                for (int ai = 0; ai < 2; ++ai)
#pragma unroll
                    for (int m = 0; m < 4; ++m) rs[ai][m] = __builtin_amdgcn_rsqf(rs[ai][m] * (1.0f / 2048.0f) + 1e-6f); }
#pragma unroll
            for (int ai = 0; ai < 2; ++ai)
#pragma unroll
                for (int m = 0; m < 4; ++m) { const int row = row0 + ai * HALF + m * 16; bf16_t* rowp = O + (size_t)row * ldc + col0;
#pragma unroll
                    for (int bj = 0; bj < 2; ++bj) { const f32x4 v0 = acc[ai][bj][m][0] * rs[ai][m], v1 = acc[ai][bj][m][1] * rs[ai][m];
                        u32x4 w; w.x = cvt_pk_bf16(v0[0], v0[1]); w.y = cvt_pk_bf16(v0[2], v0[3]); w.z = cvt_pk_bf16(v1[0], v1[1]); w.w = cvt_pk_bf16(v1[2], v1[3]);
                        *(u32x4*)(rowp + bj * HALF) = w; } }
        } else if constexpr (mode == 1) {
            const int col0 = u.pn * BM + wc * 32 + 8 * fq;
            float sc8[2][4];
#pragma unroll
            for (int ai = 0; ai < 2; ++ai)
#pragma unroll
                for (int m = 0; m < 4; ++m) sc8[ai][m] = ss ? ss[row0 + ai * HALF + m * 16] : 1.0f;
            if (ss) {
#pragma unroll
                for (int ai = 0; ai < 2; ++ai)
#pragma unroll
                    for (int m = 0; m < 4; ++m) sc8[ai][m] = __builtin_amdgcn_rsqf(sc8[ai][m] * (1.0f / 2048.0f) + 1e-6f); }
#pragma unroll
            for (int ai = 0; ai < 2; ++ai)
#pragma unroll
                for (int m = 0; m < 4; ++m) { const int row = row0 + ai * HALF + m * 16; const size_t off = (size_t)row * 2048 + col0;
                    const float sc = sc8[ai][m];
                    float ssq = 0.f;
#pragma unroll
                    for (int bj = 0; bj < 2; ++bj) { f32x4 r0, r1;
                        if (resb) { const u32x4 rw = *(const u32x4*)(resb + off + bj * HALF);
                            r0 = (f32x4){__uint_as_float(rw.x << 16), __uint_as_float(rw.x & 0xffff0000u), __uint_as_float(rw.y << 16), __uint_as_float(rw.y & 0xffff0000u)};
                            r1 = (f32x4){__uint_as_float(rw.z << 16), __uint_as_float(rw.z & 0xffff0000u), __uint_as_float(rw.w << 16), __uint_as_float(rw.w & 0xffff0000u)}; }
                        else { r0 = *(const f32x4*)(res + off + bj * HALF); r1 = *(const f32x4*)(res + off + bj * HALF + 4); }
                        const f32x4 o0 = r0 + acc[ai][bj][m][0] * sc, o1 = r1 + acc[ai][bj][m][1] * sc;
                        if (out) { *(f32x4*)(out + off + bj * HALF) = o0; *(f32x4*)(out + off + bj * HALF + 4) = o1; }
                        ssq += ((o0[0] * o0[0] + o0[1] * o0[1]) + (o0[2] * o0[2] + o0[3] * o0[3])) + ((o1[0] * o1[0] + o1[1] * o1[1]) + (o1[2] * o1[2] + o1[3] * o1[3]));
                        if (hb) { u32x4 w; w.x = cvt_pk_bf16(o0[0], o0[1]); w.y = cvt_pk_bf16(o0[2], o0[3]); w.z = cvt_pk_bf16(o1[0], o1[1]); w.w = cvt_pk_bf16(o1[2], o1[3]); *(u32x4*)(hb + off + bj * HALF) = w; } }
                    if (ssp_out) { ssq += __shfl_xor(ssq, 16); ssq += __shfl_xor(ssq, 32); if (fq == 0) unsafeAtomicAdd(ssp_out + row, ssq); }
                    asm volatile("" ::: "memory"); }
        } else if constexpr (mode == 3) {
            const int cbase = u.pn * 128 + wc * 32 + 8 * fq;
            f32x4 WG[2][3], WV[2][3]; float rsa[2][4];
#pragma unroll
            for (int n = 0; n < 2; ++n)
#pragma unroll
                for (int k = 0; k < 3; ++k) { WG[n][k] = *(const f32x4*)(cw + k * 11264 + cbase + 4 * n); WV[n][k] = *(const f32x4*)(cw + k * 11264 + 5632 + cbase + 4 * n); }
#pragma unroll
            for (int ai = 0; ai < 2; ++ai)
#pragma unroll
                for (int m = 0; m < 4; ++m) rsa[ai][m] = ssp_in[row0 + ai * HALF + m * 16];
#pragma unroll
            for (int ai = 0; ai < 2; ++ai) {
                float rs[4];
#pragma unroll
                for (int m = 0; m < 4; ++m) rs[m] = __builtin_amdgcn_rsqf(rsa[ai][m] * (1.0f / 2048.0f) + 1e-6f);
                unsigned op[2][4][2];
#pragma unroll
                for (int n = 0; n < 2; ++n) {
                    const f32x4 wg0 = WG[n][0], wg1 = WG[n][1], wg2 = WG[n][2], wv0 = WV[n][0], wv1 = WV[n][1], wv2 = WV[n][2];
#pragma unroll
                    for (int jp = 0; jp < 2; ++jp) {
                        const f32x2 g0 = {wg0[2 * jp], wg0[2 * jp + 1]}, g1 = {wg1[2 * jp], wg1[2 * jp + 1]}, g2 = {wg2[2 * jp], wg2[2 * jp + 1]};
                        const f32x2 h0 = {wv0[2 * jp], wv0[2 * jp + 1]}, h1 = {wv1[2 * jp], wv1[2 * jp + 1]}, h2 = {wv2[2 * jp], wv2[2 * jp + 1]};
                        f32x2 cg[4], cv[4];
                        { f32x2 x[4];
#pragma unroll
                          for (int m = 0; m < 4; ++m) x[m] = (f32x2){acc[ai][0][m][n][2 * jp], acc[ai][0][m][n][2 * jp + 1]} * rs[m];
                          f32x2 q1 = {0.f, 0.f}, q2 = {0.f, 0.f};
#pragma unroll
                          for (int m = 0; m < 4; ++m) { f32x2 x1, x2; x1.x = shr_keep<1>(q1.x, x[m].x); x1.y = shr_keep<1>(q1.y, x[m].y); x2.x = shr_keep<2>(q2.x, x[m].x); x2.y = shr_keep<2>(q2.y, x[m].y);
                              cg[m] = g0 * x2 + g1 * x1 + g2 * x[m]; if (m < 3) { q1.x = ror1(x[m].x); q1.y = ror1(x[m].y); q2.x = ror2(x[m].x); q2.y = ror2(x[m].y); } } }
                        { f32x2 y[4];
#pragma unroll
                          for (int m = 0; m < 4; ++m) y[m] = (f32x2){acc[ai][1][m][n][2 * jp], acc[ai][1][m][n][2 * jp + 1]} * rs[m];
                          f32x2 q1 = {0.f, 0.f}, q2 = {0.f, 0.f};
#pragma unroll
                          for (int m = 0; m < 4; ++m) { f32x2 y1, y2; y1.x = shr_keep<1>(q1.x, y[m].x); y1.y = shr_keep<1>(q1.y, y[m].y); y2.x = shr_keep<2>(q2.x, y[m].x); y2.y = shr_keep<2>(q2.y, y[m].y);
                              cv[m] = h0 * y2 + h1 * y1 + h2 * y[m]; if (m < 3) { q1.x = ror1(y[m].x); q1.y = ror1(y[m].y); q2.x = ror2(y[m].x); q2.y = ror2(y[m].y); } } }
#pragma unroll
                        for (int m = 0; m < 4; ++m) { f32x2 sg; sg.x = __builtin_amdgcn_rcpf(1.0f + __expf(-cg[m].x)); sg.y = __builtin_amdgcn_rcpf(1.0f + __expf(-cg[m].y));
                            const f32x2 o = cg[m] * sg * cv[m]; op[n][m][jp] = cvt_pk_bf16(o.x, o.y); }
                        __builtin_amdgcn_sched_barrier(0);
                    }
                }
#pragma unroll
                for (int m = 0; m < 4; ++m) { const size_t row = (size_t)(row0 + ai * HALF + m * 16);
                    if (m > 0 || fr >= 2) { u32x4 w; w.x = op[0][m][0]; w.y = op[0][m][1]; w.z = op[1][m][0]; w.w = op[1][m][1]; *(u32x4*)(O + row * 5632 + cbase) = w; }
                    if ((m == 0 && fr < 2) || (m == 3 && fr >= 14)) { const f32x4 xg0 = acc[ai][0][m][0] * rs[m], xg1 = acc[ai][0][m][1] * rs[m], yv0 = acc[ai][1][m][0] * rs[m], yv1 = acc[ai][1][m][1] * rs[m];
                        u32x4 w; w.x = cvt_pk_bf16(xg0[0], xg0[1]); w.y = cvt_pk_bf16(xg0[2], xg0[3]); w.z = cvt_pk_bf16(xg1[0], xg1[1]); w.w = cvt_pk_bf16(xg1[2], xg1[3]); *(u32x4*)(Ub + row * 11264 + cbase) = w;
                        w.x = cvt_pk_bf16(yv0[0], yv0[1]); w.y = cvt_pk_bf16(yv0[2], yv0[3]); w.z = cvt_pk_bf16(yv1[0], yv1[1]); w.w = cvt_pk_bf16(yv1[2], yv1[3]); *(u32x4*)(Ub + row * 11264 + 5632 + cbase) = w; } }
                __builtin_amdgcn_sched_barrier(0);
            }
        } else if constexpr (mode == 4) {
            if (u.pn & 4) {
                const int t = 16 + (u.pn >> 3) * 4 + (u.pn & 3); const bool isv = t < 24; bf16_t* base = isv ? V : G; const int col0 = ((t - 16) & 7) * BM + wc * 32 + 8 * fq;
#pragma unroll
                for (int ai = 0; ai < 2; ++ai)
#pragma unroll
                    for (int m = 0; m < 4; ++m) { bf16_t* rowp = base + (size_t)(row0 + ai * HALF + m * 16) * 2048 + col0;
#pragma unroll
                        for (int bj = 0; bj < 2; ++bj) { f32x4 v0 = acc[ai][bj][m][0], v1 = acc[ai][bj][m][1];
                            if (!isv) {
#pragma unroll
                                for (int j = 0; j < 4; ++j) { v0[j] = v0[j] * __builtin_amdgcn_rcpf(1.0f + __expf(-v0[j])); v1[j] = v1[j] * __builtin_amdgcn_rcpf(1.0f + __expf(-v1[j])); } }
                            u32x4 w; w.x = cvt_pk_bf16(v0[0], v0[1]); w.y = cvt_pk_bf16(v0[2], v0[3]); w.z = cvt_pk_bf16(v1[0], v1[1]); w.w = cvt_pk_bf16(v1[2], v1[3]);
                            *(u32x4*)(rowp + bj * HALF) = w; } }
            } else {
                const int h = (u.pn >> 3) * 4 + (u.pn & 3), cl = wc * 32 + 8 * fq;
                f32x4 lb[2];
#pragma unroll
                for (int n = 0; n < 2; ++n) { const float* p = lbt + h * 128 + cl + 4 * n; const f32x4 t0 = *(const f32x4*)p, t1 = *(const f32x4*)(p + 2048), t2 = *(const f32x4*)(p + 4096);
#pragma unroll
                    for (int j = 0; j < 4; ++j) { const float mx = fmaxf(t0[j], fmaxf(t1[j], t2[j])); const float e0 = __expf(t0[j] - mx), e1 = __expf(t1[j] - mx), e2 = __expf(t2[j] - mx); lb[n][j] = e0 / (e0 + e1 + e2); } }
#pragma unroll
                for (int ai = 0; ai < 2; ++ai) {
                    const int m0 = u.pm * BM + ai * HALF + wr * 64;
                    const int task = ((m0 >> 12) * 16 + h) * 64 + ((m0 & 4095) >> 6);
                    unsigned qp[2][4][2], kp[2][4][2];
#pragma unroll
                    for (int n = 0; n < 2; ++n) {
                        f32x4 er, ebr, dec;
#pragma unroll
                        for (int jp = 0; jp < 2; ++jp) {
                            float qo[4][2], ko[4][2];
#pragma unroll
                            for (int e = 0; e < 2; ++e) { const int j = jp * 2 + e; const float l = lb[n][j];
                                float kk[4], bb[4];
#pragma unroll
                                for (int m = 0; m < 4; ++m) { const float a = acc[ai][1][m][n][j]; const float sg = __builtin_amdgcn_rcpf(1.0f + __expf(-a)); const float f = l + (1.0f - l) * sg; kk[m] = 1.0f - f;
                                    float s = __builtin_amdgcn_logf(f) * 0.6931471805599453f;     s += shr_dpp<1>(s); s += shr_dpp<2>(s); s += shr_dpp<4>(s); s += shr_dpp<8>(s); bb[m] = s; }
                                const float t0 = bc15_dpp(bb[0]), t1 = bc15_dpp(bb[1]), t2 = bc15_dpp(bb[2]), t3 = bc15_dpp(bb[3]);
                                const float c1 = t0 + t1; bb[1] += t0; bb[2] += c1; bb[3] += c1 + t2; const float bl = (c1 + t2) + t3;
                                const float r = c1;
#pragma unroll
                                for (int m = 0; m < 4; ++m) { const float aq = acc[ai][0][m][n][j]; const float qv = aq * __builtin_amdgcn_rcpf(1.0f + __expf(-aq)) * 0.08838834764831845f; const float e1 = __expf(bb[m] - r);
                                    qo[m][e] = qv * e1; ko[m][e] = kk[m] * __builtin_amdgcn_rcpf(e1); }
                                er[j] = __expf(r); ebr[j] = __expf(bl - r); dec[j] = __expf(bl);
                            }
#pragma unroll
                            for (int m = 0; m < 4; ++m) { qp[n][m][jp] = cvt_pk_bf16(qo[m][0], qo[m][1]); kp[n][m][jp] = cvt_pk_bf16(ko[m][0], ko[m][1]); }
                        }
                        if (fr == 0) { float* vp = LOGF + (size_t)task * 128 + cl + 4 * n; *(f32x4*)vp = er; *(f32x4*)(vp + 2048 * 128) = ebr; *(f32x4*)(vp + 2 * 2048 * 128) = dec; }
                        __builtin_amdgcn_sched_barrier(0);
                    }
#pragma unroll
                    for (int m = 0; m < 4; ++m) { const size_t off = (size_t)(row0 + ai * HALF + m * 16) * 2048 + h * 128 + cl;
                        u32x4 w; w.x = qp[0][m][0]; w.y = qp[0][m][1]; w.z = qp[1][m][0]; w.w = qp[1][m][1]; *(u32x4*)(Q + off) = w;
                        w.x = kp[0][m][0]; w.y = kp[0][m][1]; w.z = kp[1][m][0]; w.w = kp[1][m][1]; *(u32x4*)(KE + off) = w; }
                }
            }
        } else {
            const int sec = u.pn >> 3, col0 = (u.pn & 7) * BM + wc * 32 + 8 * fq;
            if (sec == 2) {
#pragma unroll
                for (int ai = 0; ai < 2; ++ai)
#pragma unroll
                    for (int m = 0; m < 4; ++m) { bf16_t* rowp = V + (size_t)(row0 + ai * HALF + m * 16) * 2048 + col0;
#pragma unroll
                        for (int bj = 0; bj < 2; ++bj) { const f32x4 v0 = acc[ai][bj][m][0], v1 = acc[ai][bj][m][1];
                            u32x4 w; w.x = cvt_pk_bf16(v0[0], v0[1]); w.y = cvt_pk_bf16(v0[2], v0[3]); w.z = cvt_pk_bf16(v1[0], v1[1]); w.w = cvt_pk_bf16(v1[2], v1[3]);
                            *(u32x4*)(rowp + bj * HALF) = w; } }
            } else if (sec == 1) {
                f32x4 lb[2][2];
#pragma unroll
                for (int bj = 0; bj < 2; ++bj)
#pragma unroll
                    for (int n = 0; n < 2; ++n) { const float* p = lbt + col0 + bj * HALF + 4 * n; const f32x4 t0 = *(const f32x4*)p, t1 = *(const f32x4*)(p + 2048), t2 = *(const f32x4*)(p + 4096);
#pragma unroll
                        for (int j = 0; j < 4; ++j) { const float mx = fmaxf(t0[j], fmaxf(t1[j], t2[j])); const float e0 = __expf(t0[j] - mx), e1 = __expf(t1[j] - mx), e2 = __expf(t2[j] - mx); lb[bj][n][j] = e0 / (e0 + e1 + e2); } }
#pragma unroll
                for (int ai = 0; ai < 2; ++ai)
#pragma unroll
                    for (int m = 0; m < 4; ++m) { float* rowp = LOGF + (size_t)(row0 + ai * HALF + m * 16) * 2048 + col0;
#pragma unroll
                        for (int bj = 0; bj < 2; ++bj)
#pragma unroll
                            for (int n = 0; n < 2; ++n) { f32x4 o;
#pragma unroll
                                for (int j = 0; j < 4; ++j) { const float a = acc[ai][bj][m][n][j]; const float sg = __builtin_amdgcn_rcpf(1.0f + __expf(-a)); const float l = lb[bj][n][j]; o[j] = __logf(l + (1.0f - l) * sg); }
                                *(f32x4*)(rowp + bj * HALF + 4 * n) = o; } }
            } else {
                bf16_t* base = sec == 0 ? Q : G; const float sc = sec == 0 ? 0.08838834764831845f : 1.0f;
#pragma unroll
                for (int ai = 0; ai < 2; ++ai)
#pragma unroll
                    for (int m = 0; m < 4; ++m) { bf16_t* rowp = base + (size_t)(row0 + ai * HALF + m * 16) * 2048 + col0;
#pragma unroll
                        for (int bj = 0; bj < 2; ++bj) { f32x4 v0 = acc[ai][bj][m][0], v1 = acc[ai][bj][m][1];
#pragma unroll
                            for (int j = 0; j < 4; ++j) { v0[j] = v0[j] * sc * __builtin_amdgcn_rcpf(1.0f + __expf(-v0[j])); v1[j] = v1[j] * sc * __builtin_amdgcn_rcpf(1.0f + __expf(-v1[j])); }
                            u32x4 w; w.x = cvt_pk_bf16(v0[0], v0[1]); w.y = cvt_pk_bf16(v0[2], v0[3]); w.z = cvt_pk_bf16(v1[0], v1[1]); w.w = cvt_pk_bf16(v1[2], v1[3]);
                            *(u32x4*)(rowp + bj * HALF) = w; } }
            }
        }
    }
};

template <class Epi, class Sched, bool ALIGN_EPI = false, bool SP2 = false>
__device__ __forceinline__ void gemm_phase(PG8_LAS unsigned char* lds, const Gemm g, const Sched& S, const Epi& E, const int wid) {
    int lane_; asm volatile("v_mbcnt_lo_u32_b32 %0, -1, 0\n\tv_mbcnt_hi_u32_b32 %0, -1, %0" : "=v"(lane_));
    const int lane = lane_, tid = wid * 64 + lane, wr = wid >> 2, wc = wid & 3, fr = lane & 15, fq = lane >> 4;
    constexpr int K = Epi::KC, nt = K / BK;
    unsigned voffA[2], voffB[2];
#pragma unroll
    for (int i = 0; i < 2; ++i) { int R, C; stage_rc(tid * 16 + i * 8192, R, C); const int Rb = Epi::PERM ? ((R & ~31) + perm32(R & 31)) : R;
        voffA[i] = (unsigned)(R * K + C) * 2u; voffB[i] = (unsigned)(Rb * K + C) * 2u; }
    const size_t kstep = (size_t)(BK * 2);
    const size_t hstep = (size_t)HALF * K * 2;
    const size_t tstep = 2 * hstep;
    const unsigned ldsw = (unsigned)wid * 1024u;
    const int aoff = lds_byte(wr * 64 + fr, fq * 8), boff = lds_byte(wc * 32 + fr, fq * 8);
#define PG8_SA(b, h) (((b) * 2 + (h)) * HTB)
#define PG8_SB(b, h) ((4 + (b) * 2 + (h)) * HTB)
#define PG8_STAGE(bufoff, gbase, voff) do { _Pragma("unroll") for (int _i = 0; _i < 2; ++_i) \
        __builtin_amdgcn_global_load_lds((const unsigned*)((const char*)(gbase) + (voff)[_i]), (PG8_LAS unsigned*)(lds + (bufoff) + ldsw + _i * 8192), 16, 0, 0); } while (0)
#define PG8_LDA(dst, b, h) do { _Pragma("unroll") for (int m = 0; m < 4; ++m) _Pragma("unroll") for (int k = 0; k < 2; ++k) dst[m][k] = *(const PG8_LAS bf16x8*)(lds + PG8_SA(b, h) + aoff + m * 2048 + k * 1024); } while (0)
#define PG8_LDB(dst, b, h) do { _Pragma("unroll") for (int n = 0; n < 2; ++n) _Pragma("unroll") for (int k = 0; k < 2; ++k) dst[n][k] = *(const PG8_LAS bf16x8*)(lds + PG8_SB(b, h) + boff + n * 2048 + k * 1024); } while (0)
#define PG8_MMA(ai, bj, At, Bt) do { __builtin_amdgcn_s_setprio(1); _Pragma("unroll") for (int m = 0; m < 4; ++m) _Pragma("unroll") for (int n = 0; n < 2; ++n) _Pragma("unroll") for (int k = 0; k < 2; ++k) \
        acc[ai][bj][m][n] = __builtin_amdgcn_mfma_f32_16x16x32_bf16(Bt[n][k], At[m][k], acc[ai][bj][m][n], 0, 0, 0); __builtin_amdgcn_s_setprio(0); } while (0)
#define PG8_WAIT_V(n) asm volatile("s_waitcnt vmcnt(" #n ")" ::: "memory")
#define PG8_WAIT_L(n) asm volatile("s_waitcnt lgkmcnt(" #n ")" ::: "memory")
#define PG8_BAR __builtin_amdgcn_s_barrier()
#define PG8_SCHED __builtin_amdgcn_sched_barrier(0)
    Unit cur, nxt; int ui = 0;
    if (!S.next(0, cur)) return;
    f32x4 acc[2][2][4][2];
#pragma unroll
    for (int a = 0; a < 2; ++a)
#pragma unroll
        for (int b = 0; b < 2; ++b)
#pragma unroll
            for (int m = 0; m < 4; ++m)
#pragma unroll
                for (int n = 0; n < 2; ++n) acc[a][b][m][n] = (f32x4){0.f, 0.f, 0.f, 0.f};
    bf16x8 At[4][2], B0[2][2], B1[2][2];
    const char* cA = (const char*)g.A + (size_t)cur.pm * tstep; const char* cB = (const char*)g.Bt + (size_t)cur.pn * tstep;
    S.a_ready(cur);
    if constexpr (SP2) {
        PG8_STAGE(PG8_SB(0, 0), cB, voffB); PG8_STAGE(PG8_SB(0, 1), cB + hstep, voffB); PG8_STAGE(PG8_SA(0, 0), cA, voffA); PG8_STAGE(PG8_SA(0, 1), cA + hstep, voffA);
        if (wr == 1) PG8_BAR;
        PG8_WAIT_V(2); PG8_BAR;
        PG8_STAGE(PG8_SB(1, 0), cB + kstep, voffB); PG8_STAGE(PG8_SA(1, 0), cA + kstep, voffA); PG8_STAGE(PG8_SB(1, 1), cB + hstep + kstep, voffB);
        PG8_WAIT_V(6); PG8_BAR;
    } else {
        PG8_STAGE(PG8_SB(0, 0), cB, voffB); PG8_STAGE(PG8_SA(0, 0), cA, voffA); PG8_STAGE(PG8_SB(0, 1), cB + hstep, voffB); PG8_STAGE(PG8_SA(0, 1), cA + hstep, voffA);
        if (wr == 1) PG8_BAR;
        PG8_WAIT_V(4); PG8_BAR;
        PG8_STAGE(PG8_SB(1, 0), cB + kstep, voffB); PG8_STAGE(PG8_SA(1, 0), cA + kstep, voffA); PG8_STAGE(PG8_SB(1, 1), cB + hstep + kstep, voffB);
        PG8_WAIT_V(6); PG8_BAR;
    }
    for (;;) {
        const bool has_next = S.next(ui + 1, nxt);
        const char* nA = has_next ? (const char*)g.A + (size_t)nxt.pm * tstep : cA; const char* nB = has_next ? (const char*)g.Bt + (size_t)nxt.pn * tstep : cB;
        for (int t = 0; t < nt; t += 2) {
            const bool last = (t == nt - 2);
            const char* a1 = cA + (size_t)(t + 1) * kstep;
            const char* a2 = last ? nA : cA + (size_t)(t + 2) * kstep; const char* b2 = last ? nB : cB + (size_t)(t + 2) * kstep;
            const char* a3 = a2 + kstep; const char* b3 = b2 + kstep;
            if (last && has_next) S.a_ready(nxt);
            if constexpr (SP2) {
            PG8_LDB(B0, 0, 0); PG8_LDB(B1, 0, 1); PG8_SCHED; PG8_LDA(At, 0, 0); PG8_STAGE(PG8_SA(1, 1), a1 + hstep, voffA);
            PG8_WAIT_V(8); PG8_WAIT_L(0); PG8_BAR; PG8_MMA(0, 0, At, B0); PG8_MMA(0, 1, At, B1); PG8_BAR; PG8_SCHED;
            PG8_LDA(At, 0, 1); PG8_STAGE(PG8_SB(0, 0), b2, voffB); PG8_STAGE(PG8_SB(0, 1), b2 + hstep, voffB); PG8_STAGE(PG8_SA(0, 0), a2, voffA);
            PG8_WAIT_V(8); PG8_WAIT_L(0); PG8_BAR; PG8_MMA(1, 0, At, B0); PG8_MMA(1, 1, At, B1); PG8_BAR; PG8_SCHED;
            PG8_LDB(B0, 1, 0); PG8_LDB(B1, 1, 1); PG8_SCHED; PG8_LDA(At, 1, 0); PG8_STAGE(PG8_SA(0, 1), a2 + hstep, voffA);
            PG8_WAIT_V(8); PG8_WAIT_L(0); PG8_BAR; PG8_MMA(0, 0, At, B0); PG8_MMA(0, 1, At, B1); PG8_BAR; PG8_SCHED;
            PG8_LDA(At, 1, 1); PG8_STAGE(PG8_SB(1, 0), b3, voffB); PG8_STAGE(PG8_SB(1, 1), b3 + hstep, voffB); PG8_STAGE(PG8_SA(1, 0), a3, voffA);
            PG8_WAIT_V(8); PG8_WAIT_L(0); PG8_BAR; PG8_MMA(1, 0, At, B0); PG8_MMA(1, 1, At, B1); PG8_BAR; PG8_SCHED;
            } else {
            PG8_LDB(B0, 0, 0); PG8_SCHED; PG8_LDA(At, 0, 0); PG8_STAGE(PG8_SA(1, 1), a1 + hstep, voffA);
            PG8_WAIT_L(8); PG8_BAR; PG8_WAIT_L(0); PG8_MMA(0, 0, At, B0); PG8_BAR; PG8_SCHED;
            PG8_LDB(B1, 0, 1); PG8_STAGE(PG8_SB(0, 0), b2, voffB);
            PG8_BAR; PG8_WAIT_L(0); PG8_MMA(0, 1, At, B1); PG8_BAR;
            PG8_LDA(At, 0, 1); PG8_STAGE(PG8_SA(0, 0), a2, voffA);
            PG8_BAR; PG8_WAIT_L(0); PG8_MMA(1, 0, At, B0); PG8_BAR; PG8_SCHED;
            PG8_STAGE(PG8_SB(0, 1), b2 + hstep, voffB);
            PG8_WAIT_V(6); PG8_BAR; PG8_MMA(1, 1, At, B1); PG8_BAR;
            PG8_LDB(B0, 1, 0); PG8_SCHED; PG8_LDA(At, 1, 0); PG8_STAGE(PG8_SA(0, 1), a2 + hstep, voffA);
            PG8_WAIT_L(8); PG8_BAR; PG8_WAIT_L(0); PG8_MMA(0, 0, At, B0); PG8_BAR; PG8_SCHED;
            PG8_LDB(B1, 1, 1); PG8_STAGE(PG8_SB(1, 0), b3, voffB);
            PG8_BAR; PG8_WAIT_L(0); PG8_MMA(0, 1, At, B1); PG8_BAR;
            PG8_LDA(At, 1, 1); PG8_STAGE(PG8_SA(1, 0), a3, voffA);
            PG8_BAR; PG8_WAIT_L(0); PG8_MMA(1, 0, At, B0); PG8_BAR; PG8_SCHED;
            PG8_STAGE(PG8_SB(1, 1), b3 + hstep, voffB);
            PG8_WAIT_V(6); PG8_BAR; PG8_MMA(1, 1, At, B1); PG8_BAR;
            }
        }
        if constexpr (ALIGN_EPI) { if (wr == 0) PG8_BAR; }
        if constexpr (!Epi::AFTER_DRAIN) { E(acc, cur, wr, wc, fr, fq); S.done(cur); }
        if (!has_next) break;
#pragma unroll
        for (int a = 0; a < 2; ++a)
#pragma unroll
            for (int b = 0; b < 2; ++b)
#pragma unroll
                for (int m = 0; m < 4; ++m)
#pragma unroll
                    for (int n = 0; n < 2; ++n) acc[a][b][m][n] = (f32x4){0.f, 0.f, 0.f, 0.f};
        cur = nxt; cA = nA; cB = nB; ++ui;
        if constexpr (ALIGN_EPI) { if (wr == 1) PG8_BAR; }
    }
    PG8_WAIT_V(0);
    if constexpr (!ALIGN_EPI) { if (wr == 0) PG8_BAR; }
    PG8_BAR;
    if constexpr (Epi::AFTER_DRAIN) { E.fused(acc, cur, wr, wc, fr, fq, lds, wid, lane); S.done(cur); }
#undef PG8_SA
#undef PG8_SB
#undef PG8_STAGE
#undef PG8_LDA
#undef PG8_LDB
#undef PG8_MMA
#undef PG8_WAIT_V
#undef PG8_WAIT_L
#undef PG8_BAR
#undef PG8_SCHED
}
}

#define LAS __attribute__((address_space(3)))
typedef unsigned short bf16;
typedef short bf16x8 __attribute__((ext_vector_type(8)));
typedef float f32x4 __attribute__((ext_vector_type(4)));
typedef unsigned u32x4 __attribute__((ext_vector_type(4)));
typedef unsigned u32x2 __attribute__((ext_vector_type(2)));
constexpr int NWAVES = 8, NTHR = 512;
constexpr int SEQ = 4096, D = 2048, M = 8192, HD = 128, FF = 5632, NIN = 8192, NSC = 6144, NUP = 11264;
constexpr int NTASK = 2048;
constexpr float EPS = 1e-6f;
constexpr int LDS_BYTES = 147456;

constexpr size_t MiB = 1u << 20;
constexpr size_t WS_WIN = 1 * MiB, WS_WOH = WS_WIN + 32 * MiB, WS_WUP0 = WS_WOH + 8 * MiB, WS_WUP1 = WS_WUP0 + 44 * MiB, WS_WDN0 = WS_WUP1 + 44 * MiB, WS_WDN1 = WS_WDN0 + 22 * MiB,
                 WS_WSI = WS_WDN1 + 22 * MiB, WS_WSO = WS_WSI + 24 * MiB, WS_XN = WS_WSO + 8 * MiB, WS_R = WS_XN + 32 * MiB;
constexpr size_t WS_Q = WS_R, WS_LOGF = WS_Q + 32 * MiB  , WS_V = WS_LOGF + 64 * MiB  , WS_G = WS_V + 32 * MiB, WS_UT = WS_G + 32 * MiB, WS_SP = WS_UT + 128 * MiB,
                 WS_DEC = WS_SP + 64 * MiB, WS_SS = WS_DEC + 1 * MiB, WS_R_END = WS_SS + 1 * MiB;
constexpr size_t WS_U = WS_R, WS_ACT = WS_U + 176 * MiB;
constexpr size_t WS_P2 = WS_R, WS_Y = WS_P2 + 96 * MiB;
constexpr size_t WS_SSP = WS_R_END, WS_QE2 = WS_SSP + 1 * MiB, WS_OI = WS_QE2 + 32 * MiB, WS_END = WS_OI + 64 * MiB;
static_assert(WS_ACT + 88 * MiB <= WS_END && WS_Y + 32 * MiB <= WS_END, "ws map");

typedef __bf16 bf16x2_t __attribute__((ext_vector_type(2)));
__device__ __forceinline__ unsigned pk_bf16(float lo, float hi) { bf16x2_t v = {(__bf16)lo, (__bf16)hi}; return __builtin_bit_cast(unsigned, v); }
__device__ __forceinline__ float bf_lo(unsigned w) { return __uint_as_float(w << 16); }
__device__ __forceinline__ float bf_hi(unsigned w) { return __uint_as_float(w & 0xffff0000u); }
__device__ __forceinline__ float bf1(bf16 h) { return __uint_as_float(((unsigned)h) << 16); }
__device__ __forceinline__ float wave_sum(float v) {
#pragma unroll
    for (int o = 1; o < 64; o <<= 1) v += __shfl_xor(v, o);
    return v;
}
__device__ __forceinline__ int lane_id() { int l; asm volatile("v_mbcnt_lo_u32_b32 %0, -1, 0\n\tv_mbcnt_hi_u32_b32 %0, -1, %0" : "=v"(l)); return l; }
__device__ __forceinline__ float silu_f(float a) { return a * __builtin_amdgcn_rcpf(1.0f + __expf(-a)); }

__device__ __forceinline__ int hg_pos(int idx, int b0) { return 8 * (idx >> 2) + b0 + (idx & 3); }
struct CvtItem { const float* W; bf16* WT; const float* wk; int K, N, item; int perm; };
__device__ __forceinline__ void cvt_load(const CvtItem& d, int lane, f32x4 (&v)[8]) {
    const int nblk = d.N / 32, kb = d.item / nblk, nb = d.item % nblk, k0 = 64 * kb, n0 = 32 * nb;
#pragma unroll
    for (int i = 0; i < 8; ++i) { const int kk = i * 8 + (lane >> 3); v[i] = __builtin_nontemporal_load((const f32x4*)(d.W + (size_t)(k0 + kk) * d.N + n0 + 4 * (lane & 7))); }
}
__device__ __forceinline__ void cvt_store(const CvtItem& d, int lane, const f32x4 (&v)[8], LAS float* scr) {
    const int nblk = d.N / 32, kb = d.item / nblk, nb = d.item % nblk, k0 = 64 * kb, n0 = 32 * nb;
    const int r0 = d.perm == 1 ? (n0 < FF ? (n0 >> 7) * 256 + (n0 & 127) : ((n0 - FF) >> 7) * 256 + 128 + ((n0 - FF) & 127))
                 : d.perm == 2 ? (n0 < 2048 ? hg_pos(n0 >> 7, 0) * 256 + (n0 & 127) : (n0 < 4096 ? hg_pos((n0 - 2048) >> 7, 0) * 256 + 128 + ((n0 - 2048) & 127) : hg_pos((n0 >> 8) - 16, 4) * 256 + (n0 & 255))) : n0;
#pragma unroll
    for (int i = 0; i < 8; ++i) { const int kk = i * 8 + (lane >> 3); LAS float* dd = scr + kk * 33 + 4 * (lane & 7); dd[0] = v[i][0]; dd[1] = v[i][1]; dd[2] = v[i][2]; dd[3] = v[i][3]; }
    asm volatile("s_waitcnt lgkmcnt(0)" ::: "memory");
    const int c = lane & 7;
    f32x4 wa = {1.f, 1.f, 1.f, 1.f}, wb = {1.f, 1.f, 1.f, 1.f};
    if (d.wk) { wa = *(const f32x4*)(d.wk + k0 + 8 * c); wb = *(const f32x4*)(d.wk + k0 + 8 * c + 4); }
#pragma unroll
    for (int j = 0; j < 4; ++j) { const int n = (lane >> 3) + 8 * j; const LAS float* s = scr + (8 * c) * 33 + n;
        u32x4 o; o.x = pk_bf16(s[0 * 33] * wa[0], s[1 * 33] * wa[1]); o.y = pk_bf16(s[2 * 33] * wa[2], s[3 * 33] * wa[3]); o.z = pk_bf16(s[4 * 33] * wb[0], s[5 * 33] * wb[1]); o.w = pk_bf16(s[6 * 33] * wb[2], s[7 * 33] * wb[3]);
        *(u32x4*)(d.WT + (size_t)(r0 + n) * d.K + k0 + 8 * c) = o; }
    asm volatile("s_waitcnt lgkmcnt(0)" ::: "memory");
}
constexpr int I_IN = (D / 64) * (NIN / 32), I_OH = (D / 64) * (D / 32), I_UP = (D / 64) * (NUP / 32), I_DN = (FF / 64) * (D / 32), I_SI = (D / 64) * (NSC / 32), I_SO = I_OH;
constexpr int P0_ITEMS = I_IN + I_OH + I_UP + I_DN + I_SI + I_SO, T3_ITEMS = I_UP + I_DN;
struct CvtSrc { const float *hin, *hout, *up, *dn, *si, *so, *nffn, *nmix; unsigned char* ws; };
__device__ __forceinline__ CvtItem p0_item(const CvtSrc& s, int r) {
    if (r < I_IN) return CvtItem{s.hin, (bf16*)(s.ws + WS_WIN), nullptr, D, NIN, r, 2}; r -= I_IN;
    if (r < I_OH) return CvtItem{s.hout, (bf16*)(s.ws + WS_WOH), nullptr, D, D, r, 0}; r -= I_OH;
    if (r < I_UP) return CvtItem{s.up, (bf16*)(s.ws + WS_WUP0), s.nffn, D, NUP, r, 1}; r -= I_UP;
    if (r < I_DN) return CvtItem{s.dn, (bf16*)(s.ws + WS_WDN0), nullptr, FF, D, r, 0}; r -= I_DN;
    if (r < I_SI) return CvtItem{s.si, (bf16*)(s.ws + WS_WSI), s.nmix + D, D, NSC, r, 0}; r -= I_SI;
    return CvtItem{s.so, (bf16*)(s.ws + WS_WSO), nullptr, D, D, r, 0};
}
__device__ __forceinline__ CvtItem t3_item(const CvtSrc& s, int r) {
    if (r < I_UP) return CvtItem{s.up + (size_t)D * NUP, (bf16*)(s.ws + WS_WUP1), s.nffn + D, D, NUP, r, 1};
    return CvtItem{s.dn + (size_t)FF * D, (bf16*)(s.ws + WS_WDN1), nullptr, FF, D, r - I_UP, 0};
}
template <bool T3> __device__ __forceinline__ void cvt_run(const CvtSrc& s, int first, int stride, int nitems, LAS float* scr, int lane) {
    if (first >= nitems) return;
    f32x4 cur[8], nxt[8];
    CvtItem dc = T3 ? t3_item(s, first) : p0_item(s, first);
    cvt_load(dc, lane, cur);
    for (int it = first; it < nitems; it += stride) {
        const bool more = it + stride < nitems;
        CvtItem dn = dc;
        if (more) { dn = T3 ? t3_item(s, it + stride) : p0_item(s, it + stride); cvt_load(dn, lane, nxt); }
        cvt_store(dc, lane, cur, scr);
        if (more) {
#pragma unroll
            for (int i = 0; i < 8; ++i) cur[i] = nxt[i];
            dc = dn; }
    }
}

__device__ __forceinline__ void rms_row_bf16(const float* xrow, const float* w, bf16* orow, int lane) {
    const f32x4* xr = (const f32x4*)xrow + lane; const f32x4* wr = (const f32x4*)w + lane;
    f32x4 v[8]; float s = 0.f;
#pragma unroll
    for (int j = 0; j < 8; ++j) { v[j] = __builtin_nontemporal_load(xr + 64 * j); s += (v[j][0] * v[j][0] + v[j][1] * v[j][1]) + (v[j][2] * v[j][2] + v[j][3] * v[j][3]); }
    f32x4 gg[8];
#pragma unroll
    for (int j = 0; j < 8; ++j) gg[j] = wr[64 * j];
    const float rstd = __builtin_amdgcn_rsqf(wave_sum(s) * (1.0f / D) + EPS);
    u32x2* o8 = (u32x2*)orow + lane;
#pragma unroll
    for (int j = 0; j < 8; ++j) { const f32x4 g = gg[j]; u32x2 o; o.x = pk_bf16(v[j][0] * rstd * g[0], v[j][1] * rstd * g[1]); o.y = pk_bf16(v[j][2] * rstd * g[2], v[j][3] * rstd * g[3]); o8[64 * j] = o; }
}
__device__ __forceinline__ void rms_row_f32(const float* xrow, const float* w, float* orow, int lane) {
    const f32x4* xr = (const f32x4*)xrow + lane; const f32x4* wr = (const f32x4*)w + lane;
    f32x4 v[8]; float s = 0.f;
#pragma unroll
    for (int j = 0; j < 8; ++j) { v[j] = xr[64 * j]; s += (v[j][0] * v[j][0] + v[j][1] * v[j][1]) + (v[j][2] * v[j][2] + v[j][3] * v[j][3]); }
    const float rstd = __builtin_amdgcn_rsqf(wave_sum(s) * (1.0f / D) + EPS);
    f32x4* o = (f32x4*)orow + lane;
#pragma unroll
    for (int j = 0; j < 8; ++j) { const f32x4 g = wr[64 * j]; o[64 * j] = v[j] * rstd * g; }
}

__device__ __forceinline__ void unpack8(const u32x4 w, float (&f)[8]) { f[0] = bf_lo(w.x); f[1] = bf_hi(w.x); f[2] = bf_lo(w.y); f[3] = bf_hi(w.y); f[4] = bf_lo(w.z); f[5] = bf_hi(w.z); f[6] = bf_lo(w.w); f[7] = bf_hi(w.w); }
__device__ __forceinline__ void load8f(const float* p, float (&f)[8]) { const f32x4 a = *(const f32x4*)p, b = *(const f32x4*)(p + 4); f[0] = a[0]; f[1] = a[1]; f[2] = a[2]; f[3] = a[3]; f[4] = b[0]; f[5] = b[1]; f[6] = b[2]; f[7] = b[3]; }
template <int RS, int SEGSTRIDE> __device__ __forceinline__ void conv_glu_phase(const bf16* U, const float* cw  , bf16* ACT, int gtid, int gthreads) {
    constexpr int NCG = FF / 8, NSEG = M / SEGSTRIDE;
    for (int it = gtid; it < NCG * NSEG; it += gthreads) {
        const int jg = it % NCG, seg = it / NCG, c0 = jg * 8, t0 = seg * SEGSTRIDE;
        const bool first = (t0 & (SEQ - 1)) == 0;
        u32x4 rg[RS + 2], rv[RS + 2];
        const bf16* up = U + (size_t)(first ? t0 : t0 - 2) * NUP + c0;
#pragma unroll
        for (int r = 0; r < RS + 2; ++r) { const size_t o = (size_t)(first ? (r < 2 ? 0 : r - 2) : r) * NUP; rg[r] = *(const u32x4*)(up + o); rv[r] = *(const u32x4*)(up + o + FF); }
        float wg[3][8], wv[3][8];
#pragma unroll
        for (int k = 0; k < 3; ++k) { load8f(cw + k * NUP + c0, wg[k]); load8f(cw + k * NUP + FF + c0, wv[k]); }
        float g2[8], g1[8], v2[8], v1[8];
        unpack8(rg[0], g2); unpack8(rg[1], g1); unpack8(rv[0], v2); unpack8(rv[1], v1);
        if (first) {
#pragma unroll
            for (int j = 0; j < 8; ++j) { g2[j] = 0.f; g1[j] = 0.f; v2[j] = 0.f; v1[j] = 0.f; }
        }
#pragma unroll
        for (int r = 0; r < RS; ++r) {
            float g0[8], v0[8];
            unpack8(rg[r + 2], g0); unpack8(rv[r + 2], v0);
            float o[8];
#pragma unroll
            for (int j = 0; j < 8; ++j) { const float cgv = wg[0][j] * g2[j] + wg[1][j] * g1[j] + wg[2][j] * g0[j]; const float cvv = wv[0][j] * v2[j] + wv[1][j] * v1[j] + wv[2][j] * v0[j];
                o[j] = silu_f(cgv) * cvv; g2[j] = g1[j]; g1[j] = g0[j]; v2[j] = v1[j]; v1[j] = v0[j]; }
            u32x4 w; w.x = pk_bf16(o[0], o[1]); w.y = pk_bf16(o[2], o[3]); w.z = pk_bf16(o[4], o[5]); w.w = pk_bf16(o[6], o[7]);
            *(u32x4*)(ACT + (size_t)(t0 + r) * FF + c0) = w;
        }
    }
}
__device__ __forceinline__ void short_conv_phase(const bf16* P2, const float* cw  , bf16* Y, int gtid, int gthreads) {
    constexpr int NCG = D / 8, RS = 8, NSEG = M / RS;
    for (int it = gtid; it < NCG * NSEG; it += gthreads) {
        const int jg = it % NCG, seg = it / NCG, c0 = jg * 8, t0 = seg * RS;
        const bool first = (t0 & (SEQ - 1)) == 0;
        u32x4 rc[RS + 2], rh[RS + 2];
        const bf16* pp = P2 + (size_t)(first ? t0 : t0 - 2) * NSC + c0;
#pragma unroll
        for (int r = 0; r < RS + 2; ++r) { const size_t o = (size_t)(first ? (r < 2 ? 0 : r - 2) : r) * NSC; rc[r] = *(const u32x4*)(pp + o + D); rh[r] = *(const u32x4*)(pp + o + 2 * D); }
        u32x4 rb[RS];
#pragma unroll
        for (int r = 0; r < 4; ++r) rb[r] = *(const u32x4*)(P2 + (size_t)(t0 + r) * NSC + c0);
        float w3[3][8];
#pragma unroll
        for (int k = 0; k < 3; ++k) load8f(cw + k * D + c0, w3[k]);
        float z2[8], z1[8];
        { float a[8], b[8]; unpack8(rc[0], a); unpack8(rh[0], b);
#pragma unroll
          for (int j = 0; j < 8; ++j) z2[j] = first ? 0.f : a[j] * b[j];
          unpack8(rc[1], a); unpack8(rh[1], b);
#pragma unroll
          for (int j = 0; j < 8; ++j) z1[j] = first ? 0.f : a[j] * b[j]; }
#pragma unroll
        for (int r = 0; r < RS; ++r) {
            float gb[8], a[8], b[8], o[8];
            if (r == 2) {
#pragma unroll
                for (int q = 4; q < RS; ++q) rb[q] = *(const u32x4*)(P2 + (size_t)(t0 + q) * NSC + c0); }
            unpack8(rb[r], gb); unpack8(rc[r + 2], a); unpack8(rh[r + 2], b);
#pragma unroll
            for (int j = 0; j < 8; ++j) { const float z0 = a[j] * b[j]; o[j] = gb[j] * (w3[0][j] * z2[j] + w3[1][j] * z1[j] + w3[2][j] * z0); z2[j] = z1[j]; z1[j] = z0; }
            u32x4 w; w.x = pk_bf16(o[0], o[1]); w.y = pk_bf16(o[2], o[3]); w.z = pk_bf16(o[4], o[5]); w.w = pk_bf16(o[6], o[7]);
            *(u32x4*)(Y + (size_t)(t0 + r) * D + c0) = w;
        }
    }
}

__device__ __forceinline__ f32x4 mma_t(const bf16x8 a, const bf16x8 b, const f32x4 c) { return __builtin_amdgcn_mfma_f32_16x16x32_bf16(b, a, c, 0, 0, 0); }
constexpr int KT_LD = 72;
constexpr int R1_KET = 0, R1_VT = R1_KET + 128 * KT_LD * 2, R1_AM = R1_VT + 128 * KT_LD * 2, R1_END = R1_AM + 64 * KT_LD * 2;
static_assert(R1_END <= 131072, "R1 LDS");

__device__ __forceinline__ void r1_phase(unsigned char* lds, const bf16* QE, const bf16* KE, const bf16* V, bf16* OINTRA, bf16* UT, int nblk, int blk, const int wid, const int lane) {
    const int tid = wid * 64 + lane, fr = lane & 15, fq = lane >> 4;
    bf16* sKET = (bf16*)(lds + R1_KET); bf16* sVT = (bf16*)(lds + R1_VT); bf16* sAM = (bf16*)(lds + R1_AM);
    const int seg = tid >> 7, d = tid & 127;
    unsigned short kn[16], vn[16];
    if (blk < NTASK) { const int bh = blk >> 6, c = blk & 63, b_ = bh >> 4, h = bh & 15, m0 = b_ * SEQ + c * 64; const size_t gb = (size_t)(m0 + seg * 16) * D + h * HD + d;
#pragma unroll
        for (int i = 0; i < 16; ++i) { kn[i] = KE[gb + (size_t)i * D]; vn[i] = V[gb + (size_t)i * D]; } }
    for (int task = blk; task < NTASK; task += nblk) {
        const int bh = task >> 6, c = task & 63, b_ = bh >> 4, h = bh & 15, m0 = b_ * SEQ + c * 64;
        bf16x8 fa[2][4], fb[2][4];
#pragma unroll
        for (int q = 0; q < 2; ++q) { const int id = wid * 2 + q, ti = id >> 2, sj = id & 3;
            if (sj <= ti) {
#pragma unroll
                for (int kk = 0; kk < 4; ++kk) { fa[q][kk] = *(const bf16x8*)(QE + (size_t)(m0 + ti * 16 + fr) * D + h * HD + kk * 32 + fq * 8); fb[q][kk] = *(const bf16x8*)(KE + (size_t)(m0 + sj * 16 + fr) * D + h * HD + kk * 32 + fq * 8); } } }
        { u32x4 w0, w1;
          w0.x = kn[0] | ((unsigned)kn[1] << 16); w0.y = kn[2] | ((unsigned)kn[3] << 16); w0.z = kn[4] | ((unsigned)kn[5] << 16); w0.w = kn[6] | ((unsigned)kn[7] << 16);
          w1.x = kn[8] | ((unsigned)kn[9] << 16); w1.y = kn[10] | ((unsigned)kn[11] << 16); w1.z = kn[12] | ((unsigned)kn[13] << 16); w1.w = kn[14] | ((unsigned)kn[15] << 16);
          *(u32x4*)(sKET + d * KT_LD + seg * 16) = w0; *(u32x4*)(sKET + d * KT_LD + seg * 16 + 8) = w1;
          w0.x = vn[0] | ((unsigned)vn[1] << 16); w0.y = vn[2] | ((unsigned)vn[3] << 16); w0.z = vn[4] | ((unsigned)vn[5] << 16); w0.w = vn[6] | ((unsigned)vn[7] << 16);
          w1.x = vn[8] | ((unsigned)vn[9] << 16); w1.y = vn[10] | ((unsigned)vn[11] << 16); w1.z = vn[12] | ((unsigned)vn[13] << 16); w1.w = vn[14] | ((unsigned)vn[15] << 16);
          *(u32x4*)(sVT + d * KT_LD + seg * 16) = w0; *(u32x4*)(sVT + d * KT_LD + seg * 16 + 8) = w1; }
        if (task + nblk < NTASK) { const int tn = task + nblk, bhn = tn >> 6, cn = tn & 63, bn = bhn >> 4, hn = bhn & 15, m0n = bn * SEQ + cn * 64; const size_t gb = (size_t)(m0n + seg * 16) * D + hn * HD + d;
#pragma unroll
            for (int i = 0; i < 16; ++i) { kn[i] = KE[gb + (size_t)i * D]; vn[i] = V[gb + (size_t)i * D]; } }
#pragma unroll
        for (int q = 0; q < 2; ++q) { const int id = wid * 2 + q, ti = id >> 2, sj = id & 3; f32x4 acc = {0.f, 0.f, 0.f, 0.f};
            if (sj <= ti) {
#pragma unroll
                for (int kk = 0; kk < 4; ++kk) acc = mma_t(fa[q][kk], fb[q][kk], acc);
                const int t = ti * 16 + fr, s0 = sj * 16 + 4 * fq;
#pragma unroll
                for (int j = 0; j < 4; ++j) if (s0 + j > t) acc[j] = 0.f;
            }
            u32x2 w; w.x = pk_bf16(acc[0], acc[1]); w.y = pk_bf16(acc[2], acc[3]);
            *(u32x2*)(sAM + (ti * 16 + fr) * KT_LD + sj * 16 + 4 * fq) = w; }
        __syncthreads();
        { const bf16x8 a0 = *(const bf16x8*)(sVT + (wid * 16 + fr) * KT_LD + fq * 8), a1 = *(const bf16x8*)(sVT + (wid * 16 + fr) * KT_LD + 32 + fq * 8);
          bf16* up = UT + (size_t)task * 16384 + (size_t)(wid * 16 + fr) * 128 + 4 * fq;
#pragma unroll
          for (int dj = 0; dj < 8; ++dj) { const bf16x8 b0 = *(const bf16x8*)(sKET + (dj * 16 + fr) * KT_LD + fq * 8), b1 = *(const bf16x8*)(sKET + (dj * 16 + fr) * KT_LD + 32 + fq * 8);
              f32x4 acc = {0.f, 0.f, 0.f, 0.f}; acc = mma_t(a0, b0, acc); acc = mma_t(a1, b1, acc); u32x2 w; w.x = pk_bf16(acc[0], acc[1]); w.y = pk_bf16(acc[2], acc[3]); *(u32x2*)(up + dj * 16) = w; } }
        { const int ti = wid >> 1; const bf16x8 a0 = *(const bf16x8*)(sAM + (ti * 16 + fr) * KT_LD + fq * 8), a1 = *(const bf16x8*)(sAM + (ti * 16 + fr) * KT_LD + 32 + fq * 8);
          bf16* op = OINTRA + (size_t)(m0 + ti * 16 + fr) * D + h * HD + 4 * fq;
#pragma unroll
          for (int q = 0; q < 4; ++q) { const int vj = (wid & 1) * 4 + q; const bf16x8 b0 = *(const bf16x8*)(sVT + (vj * 16 + fr) * KT_LD + fq * 8), b1 = *(const bf16x8*)(sVT + (vj * 16 + fr) * KT_LD + 32 + fq * 8);
              f32x4 acc = {0.f, 0.f, 0.f, 0.f}; acc = mma_t(a0, b0, acc); acc = mma_t(a1, b1, acc); u32x2 w; w.x = pk_bf16(acc[0], acc[1]); w.y = pk_bf16(acc[2], acc[3]); *(u32x2*)(op + vj * 16) = w; } }
        __syncthreads();
    }
}
__device__ __forceinline__ void r2_phase(const bf16* UT, const float* VEC, bf16* SP, int gtid, int gthreads) {
    for (int e = gtid; e < 32 * 4096; e += gthreads) {
        const int bh = e >> 12, rem = e & 4095, d4 = (rem & 31) * 4;
        f32x4 S = {0.f, 0.f, 0.f, 0.f};
        for (int c0 = 0; c0 < 64; c0 += 8) {
            u32x2 uw[8]; f32x4 er[8], ebr[8], dc[8];
#pragma unroll
            for (int i = 0; i < 8; ++i) { const size_t task = (size_t)bh * 64 + c0 + i;
                uw[i] = *(const u32x2*)(UT + task * 16384 + (size_t)rem * 4);
                er[i] = *(const f32x4*)(VEC + task * 128 + d4); ebr[i] = *(const f32x4*)(VEC + 2048 * 128 + task * 128 + d4); dc[i] = *(const f32x4*)(VEC + 2 * 2048 * 128 + task * 128 + d4); }
#pragma unroll
            for (int i = 0; i < 8; ++i) { const size_t task = (size_t)bh * 64 + c0 + i;
                const f32x4 Sp = S * er[i];
                u32x2 w; w.x = pk_bf16(Sp[0], Sp[1]); w.y = pk_bf16(Sp[2], Sp[3]); *(u32x2*)(SP + task * 16384 + (size_t)rem * 4) = w;
                const f32x4 u = {bf_lo(uw[i].x), bf_hi(uw[i].x), bf_lo(uw[i].y), bf_hi(uw[i].y)};
                S = dc[i] * S + ebr[i] * u; }
        }
    }
}
struct R3Set { bf16x8 a[4]; bf16x8 b[4][4]; u32x2 oi[4]; u32x2 g[4]; };
__device__ __forceinline__ void r3_load(R3Set& s, int un, const bf16* QE2, const bf16* SP, const bf16* OINTRA, const bf16* G, int fr, int fq) {
    const int task = un >> 3, ti = (un >> 1) & 3, half = un & 1, bh = task >> 6, c = task & 63, b_ = bh >> 4, h = bh & 15, row = b_ * SEQ + c * 64 + ti * 16 + fr;
    const bf16* ap = QE2 + (size_t)row * D + h * HD + fq * 8;
#pragma unroll
    for (int kk = 0; kk < 4; ++kk) s.a[kk] = *(const bf16x8*)(ap + kk * 32);
    const bf16* sp = SP + (size_t)task * 16384 + (size_t)(half * 64 + fr) * 128 + fq * 8; const size_t obase = (size_t)row * D + h * HD + half * 64 + 4 * fq;
#pragma unroll
    for (int q = 0; q < 4; ++q) { s.oi[q] = *(const u32x2*)(OINTRA + obase + q * 16); s.g[q] = *(const u32x2*)(G + obase + q * 16);
#pragma unroll
        for (int kk = 0; kk < 4; ++kk) s.b[q][kk] = *(const bf16x8*)(sp + (size_t)q * 16 * 128 + kk * 32); }
}
__device__ __forceinline__ void r3_phase(const bf16* QE2, const bf16* SP, const bf16* OINTRA, const bf16* G, const float* gain, bf16* OG, float* SSO, int gw, int ngw, int lane) {
    const int fr = lane & 15, fq = lane >> 4;
    R3Set cur, nxt;
    if (gw < NTASK * 8) r3_load(cur, gw, QE2, SP, OINTRA, G, fr, fq);
    for (int un = gw; un < NTASK * 8; un += ngw) {
        const bool more = un + ngw < NTASK * 8;
        if (more) r3_load(nxt, un + ngw, QE2, SP, OINTRA, G, fr, fq);
        const int task = un >> 3, ti = (un >> 1) & 3, half = un & 1, bh = task >> 6, c = task & 63, b_ = bh >> 4, h = bh & 15, row = b_ * SEQ + c * 64 + ti * 16 + fr;
        const size_t obase = (size_t)row * D + h * HD + half * 64 + 4 * fq;
        float ssum = 0.f;
#pragma unroll
        for (int q = 0; q < 4; ++q) { f32x4 acc = {bf_lo(cur.oi[q].x), bf_hi(cur.oi[q].x), bf_lo(cur.oi[q].y), bf_hi(cur.oi[q].y)};
            const f32x4 gn = *(const f32x4*)(gain + h * HD + half * 64 + q * 16 + 4 * fq);
#pragma unroll
            for (int kk = 0; kk < 4; ++kk) acc = mma_t(cur.a[kk], cur.b[q][kk], acc);
            ssum += (acc[0] * acc[0] + acc[1] * acc[1]) + (acc[2] * acc[2] + acc[3] * acc[3]);
            u32x2 w; w.x = pk_bf16(acc[0] * gn[0] * bf_lo(cur.g[q].x), acc[1] * gn[1] * bf_hi(cur.g[q].x)); w.y = pk_bf16(acc[2] * gn[2] * bf_lo(cur.g[q].y), acc[3] * gn[3] * bf_hi(cur.g[q].y));
            *(u32x2*)(OG + obase + q * 16) = w; }
        ssum += __shfl_xor(ssum, 16); ssum += __shfl_xor(ssum, 32);
        if (fq == 0) unsafeAtomicAdd(SSO + row, ssum);
        if (more) cur = nxt;
    }
}

#define XB_TMO      128
#define XB_XCNT(j)  (256  + 64 * (j))
#define XB_XSUB(j)  (1280 + 64 * (j))
#define XB_XGEN(j)  (2304 + 64 * (j))
#define XB_TOP      3328
#define XB_TOPGEN   3392
#define XCD_BAR_WORDS 3456
#define XB_SPIN_CAP (1u << 20)
__device__ __forceinline__ unsigned xb_ld(unsigned* p)              { return __hip_atomic_load(p, __ATOMIC_RELAXED, __HIP_MEMORY_SCOPE_AGENT); }
__device__ __forceinline__ unsigned xb_add(unsigned* p, unsigned v) { return __hip_atomic_fetch_add(p, v, __ATOMIC_RELAXED, __HIP_MEMORY_SCOPE_AGENT); }
__device__ __forceinline__ unsigned xb_xcc_id() { return (unsigned)__builtin_amdgcn_s_getreg((3 << 11) | 20) & 0xFu; }
#define XB_SPIN(cond, bar) do { unsigned _sp = 0; while (cond) { __builtin_amdgcn_s_sleep(1); \
    if ((++_sp & 255u) == 0u) { if (xb_ld(&(bar)[XB_TMO])) break; if (_sp > XB_SPIN_CAP) { atomicAdd(&(bar)[XB_TMO], 1u); break; } } } } while (0)
__device__ __forceinline__ void xcd_barrier_complete(unsigned* bar, unsigned x, unsigned G, unsigned& nloc, unsigned& nx) {
    unsigned sum, cnt, mine, sp = 0u;
    for (;;) {
        sum = 0u; cnt = 0u; mine = 0u;
#pragma unroll
        for (unsigned j = 0; j < 16; ++j) { const unsigned c = xb_ld(&bar[XB_XCNT(j)]); sum += c; cnt += (c > 0u) ? 1u : 0u; mine = (j == x) ? c : mine; }
        if (sum == G) break;
        __builtin_amdgcn_s_sleep(1);
        if ((++sp & 255u) == 0u) { if (xb_ld(&bar[XB_TMO])) break; if (sp > XB_SPIN_CAP) { atomicAdd(&bar[XB_TMO], 1u); break; } }
    }
    nloc = mine > 0u ? mine : 1u; nx = cnt > 0u ? cnt : 1u;
}
__device__ __forceinline__ void xcd_barrier(unsigned* bar, volatile LAS unsigned* st, int wave, unsigned G) {
    asm volatile("s_waitcnt vmcnt(0)" ::: "memory");
    __syncthreads();
    if (wave == 0 && lane_id() == 0) {
        const unsigned x = xb_xcc_id();
        __builtin_amdgcn_s_waitcnt(0);
        unsigned nloc = st[0], nx = st[1];
        if (nloc == 0u) { xcd_barrier_complete(bar, x, G, nloc, nx); st[0] = nloc; st[1] = nx; }
        const unsigned old = xb_add(&bar[XB_XSUB(x)], 1u);
        const unsigned gen = old / nloc;
        if (old + 1u == (gen + 1u) * nloc) {
            __builtin_amdgcn_fence(__ATOMIC_RELEASE, "agent");
            asm volatile("s_waitcnt vmcnt(0)" ::: "memory");
            const unsigned og = xb_add(&bar[XB_TOP], 1u);
            const unsigned tg = og / nx;
            if (og + 1u == (tg + 1u) * nx) xb_add(&bar[XB_TOPGEN], 1u);
            else XB_SPIN(xb_ld(&bar[XB_TOPGEN]) == tg, bar);
            __builtin_amdgcn_fence(__ATOMIC_ACQUIRE, "agent");
            xb_add(&bar[XB_XGEN(x)], 1u);
            asm volatile("s_waitcnt vmcnt(0)" ::: "memory");
        } else {
            XB_SPIN(xb_ld(&bar[XB_XGEN(x)]) == gen, bar);
            __builtin_amdgcn_fence(__ATOMIC_ACQUIRE, "agent");
            asm volatile("s_waitcnt vmcnt(0)" ::: "memory");
        }
    }
    __syncthreads();
}

enum { PH_P0 = 0, PH_G1, PH_R1, PH_R2, PH_R3, PH_G2, PH_N1, PH_G3, PH_C1, PH_G4, PH_N2, PH_G5, PH_C2, PH_G6, PH_N3, PH_G7, PH_C3, PH_G8, PH_FN, NPH };
struct Args { const float* in[14]; float* out; unsigned char* ws; int ph_lo, ph_hi; };

__global__ void __launch_bounds__(NTHR, 2) trunk_fwd(Args args) {
    extern __shared__ __attribute__((aligned(16))) unsigned char lds[];
    const int wave = __builtin_amdgcn_readfirstlane(threadIdx.x >> 6);
    const int G_ = gridDim.x, blk = blockIdx.x, ngw = G_ * NWAVES, gthreads = G_ * NTHR;
#define LANE_SETUP() int lane = lane_id(); asm volatile("" : "+v"(lane)); const int tid = wave * 64 + lane, gw = blk * NWAVES + wave, gtid = blk * NTHR + tid; (void)tid; (void)gw; (void)gtid
    unsigned char* ws = args.ws;
    float* H = args.out;
    bf16* XN = (bf16*)(ws + WS_XN);
    const int lo = args.ph_lo, hi = args.ph_hi;
#define IN(k) (lo <= (k) && (k) < hi)
    if (lo < 0) cg::this_grid().sync();
    volatile LAS unsigned* bst = (volatile LAS unsigned*)((LAS unsigned char*)lds + 131072 + 1024);
    unsigned* bar = (unsigned*)ws;
    {
        if (wave == 0) { const int l0 = lane_id(); if (l0 < 2) bst[l0] = 0u; if (l0 == 0) (void)xb_add(&bar[XB_XCNT(xb_xcc_id())], 1u); }
        __syncthreads();
    }
#define SEAM(k) do { xcd_barrier(bar, bst, wave, (unsigned)G_); } while (0)
#define RUN_GEMM(MODE, KC, Aptr, Bptr, NN, SETUP) do { pg8::Gemm g{(const bf16*)(Aptr), (const bf16*)(Bptr), M, (NN), (KC)}; pg8::Epi<MODE, KC> E{}; SETUP; \
        pg8::StaticOrder S; S.init(M, (NN), G_, blk); pg8::gemm_phase<pg8::Epi<MODE, KC>, pg8::StaticOrder, true, true>((LAS unsigned char*)lds, g, S, E, wave); } while (0)
    { LANE_SETUP();
        LAS float* scr = (LAS float*)((LAS unsigned char*)lds + wave * 16384);
        { const CvtSrc cs{args.in[3], args.in[6], args.in[10], args.in[12], args.in[7], args.in[9], args.in[2], args.in[1], ws};
          cvt_run<false>(cs, gw, ngw, P0_ITEMS, scr, lane); }
        {
            const f32x4* wr = (const f32x4*)args.in[1] + lane; f32x4 gg[8];
#pragma unroll
            for (int j = 0; j < 8; ++j) gg[j] = wr[64 * j];
            for (int m = gw; m < M; m += 2 * ngw) { const int m1 = m + ngw; const bool two = m1 < M;
                const f32x4* x0 = (const f32x4*)(args.in[0] + (size_t)m * D) + lane; const f32x4* x1 = (const f32x4*)(args.in[0] + (size_t)(two ? m1 : m) * D) + lane;
                f32x4 v0[8], v1[8]; float s0 = 0.f, s1 = 0.f;
#pragma unroll
                for (int j = 0; j < 8; ++j) { v0[j] = __builtin_nontemporal_load(x0 + 64 * j); v1[j] = __builtin_nontemporal_load(x1 + 64 * j); }
#pragma unroll
                for (int j = 0; j < 8; ++j) { s0 += (v0[j][0] * v0[j][0] + v0[j][1] * v0[j][1]) + (v0[j][2] * v0[j][2] + v0[j][3] * v0[j][3]); s1 += (v1[j][0] * v1[j][0] + v1[j][1] * v1[j][1]) + (v1[j][2] * v1[j][2] + v1[j][3] * v1[j][3]); }
                const float r0 = __builtin_amdgcn_rsqf(wave_sum(s0) * (1.0f / D) + EPS), r1 = __builtin_amdgcn_rsqf(wave_sum(s1) * (1.0f / D) + EPS);
                u32x2* o0 = (u32x2*)(XN + (size_t)m * D) + lane; u32x2* o1 = (u32x2*)(XN + (size_t)m1 * D) + lane;
#pragma unroll
                for (int j = 0; j < 8; ++j) { const f32x4 g = gg[j]; u32x2 o; o.x = pk_bf16(v0[j][0] * r0 * g[0], v0[j][1] * r0 * g[1]); o.y = pk_bf16(v0[j][2] * r0 * g[2], v0[j][3] * r0 * g[3]); o0[64 * j] = o;
                    if (two) { u32x2 p; p.x = pk_bf16(v1[j][0] * r1 * g[0], v1[j][1] * r1 * g[1]); p.y = pk_bf16(v1[j][2] * r1 * g[2], v1[j][3] * r1 * g[3]); o1[64 * j] = p; } }
            }
        }
        for (int i = gtid; i < 5 * M; i += gthreads) ((float*)(ws + WS_SSP))[i] = 0.f;
        SEAM(PH_P0);
    }
#pragma nounroll
    for (int L = 0; L < 2; ++L) {
        if (L == 0) {
            RUN_GEMM(4, 2048, XN, ws + WS_WIN, NIN, (E.Q = (bf16*)(ws + WS_Q), E.KE = (bf16*)(ws + WS_LOGF), E.LOGF = (float*)(ws + WS_LOGF + 32 * MiB), E.V = (bf16*)(ws + WS_V), E.G = (bf16*)(ws + WS_G), E.lbt = args.in[4]));
            SEAM(PH_G1);
            { LANE_SETUP();
              r1_phase(lds, (const bf16*)(ws + WS_Q), (const bf16*)(ws + WS_LOGF), (const bf16*)(ws + WS_V), (bf16*)(ws + WS_OI), (bf16*)(ws + WS_UT), G_, blk, wave, lane); }
            SEAM(PH_R1);
            { LANE_SETUP();
              r2_phase((const bf16*)(ws + WS_UT), (const float*)(ws + WS_LOGF + 32 * MiB), (bf16*)(ws + WS_SP), gtid, gthreads); }
            SEAM(PH_R2);
            { LANE_SETUP();
              r3_phase((const bf16*)(ws + WS_Q), (const bf16*)(ws + WS_SP), (const bf16*)(ws + WS_OI), (const bf16*)(ws + WS_G), args.in[5], (bf16*)(ws + WS_V), (float*)(ws + WS_SSP) + 3 * M, gw, ngw, lane); }
            SEAM(PH_R3);
        } else {
            RUN_GEMM(0, 2048, XN, ws + WS_WSI, NSC, (E.O = (bf16*)(ws + WS_P2), E.ldc = NSC, E.ssp_in = (const float*)(ws + WS_SSP) + 1 * M));
            SEAM(PH_G5);
            { LANE_SETUP();
              short_conv_phase((const bf16*)(ws + WS_P2), args.in[8], (bf16*)(ws + WS_Y), gtid, gthreads); }
            SEAM(PH_C2);
        }
        RUN_GEMM(1, 2048, ws + (L ? WS_Y : WS_V), ws + (L ? WS_WSO : WS_WOH), D, (E.out = nullptr, E.res = args.in[0], E.resb = L ? (const bf16*)XN : (const bf16*)nullptr, E.ss = L ? (const float*)nullptr : (const float*)(ws + WS_SSP) + 3 * M, E.hb = XN, E.ssp_out = (float*)(ws + WS_SSP) + (L ? 2 * M : 0)));
        SEAM(PH_G2);
        RUN_GEMM(3, 2048, XN, ws + (L ? WS_WUP1 : WS_WUP0), NUP, (E.O = (bf16*)(ws + WS_ACT), E.Ub = (bf16*)(ws + WS_U), E.cw = args.in[11] + (L ? 3 * NUP : 0), E.ssp_in = (const float*)(ws + WS_SSP) + (L ? 2 * M : 0)));
        if (L == 0) {
            const int nrem = ((NUP / 256) * (M / 256)) % G_, first_idle = nrem, nconv = G_ - first_idle;
            if (blk >= first_idle) { LANE_SETUP();
                LAS float* scr = (LAS float*)((LAS unsigned char*)lds + wave * 16384);
                const CvtSrc cs{args.in[3], args.in[6], args.in[10], args.in[12], args.in[7], args.in[9], args.in[2], args.in[1], ws};
                cvt_run<true>(cs, (blk - first_idle) * NWAVES + wave, nconv * NWAVES, T3_ITEMS, scr, lane); }
        }
        SEAM(PH_G3);
        { LANE_SETUP();
          conv_glu_phase<2, 64>((const bf16*)(ws + WS_U), args.in[11] + (L ? 3 * NUP : 0), (bf16*)(ws + WS_ACT), gtid, gthreads); }
        SEAM(PH_C1);
        RUN_GEMM(1, 5632, ws + WS_ACT, ws + (L ? WS_WDN1 : WS_WDN0), D, (E.out = nullptr, E.res = nullptr, E.resb = XN, E.ss = nullptr, E.hb = XN, E.ssp_out = (float*)(ws + WS_SSP) + (L ? 4 * M : 1 * M)));
        SEAM(PH_G4);
    }
    { LANE_SETUP();
        const float* ssq = (const float*)(ws + WS_SSP) + 4 * M; const f32x4* wr = (const f32x4*)args.in[13];
        for (int it = gtid; it < M * (D / 8); it += gthreads) { const int row = it >> 8, c8 = (it & 255) * 8;
            const u32x4 hw = __builtin_nontemporal_load((const u32x4*)(XN + (size_t)row * D + c8)); const float rstd = __builtin_amdgcn_rsqf(ssq[row] * (1.0f / D) + EPS);
            const f32x4 g0 = wr[c8 >> 2], g1 = wr[(c8 >> 2) + 1];
            f32x4 o0 = {bf_lo(hw.x), bf_hi(hw.x), bf_lo(hw.y), bf_hi(hw.y)}, o1 = {bf_lo(hw.z), bf_hi(hw.z), bf_lo(hw.w), bf_hi(hw.w)};
            o0 = o0 * rstd * g0; o1 = o1 * rstd * g1;
            f32x4* op = (f32x4*)(H + (size_t)row * D + c8); __builtin_nontemporal_store(o0, op); __builtin_nontemporal_store(o1, op + 1); }
    }
#undef IN
#undef LANE_SETUP
#undef SEAM
#undef RUN_GEMM
}

extern "C" void kernel_launch(void* const* d_in, const int* in_sizes, int n_in, void* d_out, int out_size, void* d_ws, size_t ws_size, hipStream_t stream) {
    static int grid = 0;
    if (grid == 0) {
        if (n_in != 14 || in_sizes[0] != M * D || out_size != M * D || ws_size < WS_END) { fprintf(stderr, "kernel_launch: unexpected shapes (n_in %d, in0 %d, out %d, ws %zu < %zu)\n", n_in, n_in > 0 ? in_sizes[0] : -1, out_size, ws_size, (size_t)WS_END); grid = -1; return; }
        int dev = 0, cus = 0, per_cu = 0;
        if (hipGetDevice(&dev) != hipSuccess || hipDeviceGetAttribute(&cus, hipDeviceAttributeMultiprocessorCount, dev) != hipSuccess) { grid = -1; return; }
        if (hipFuncSetAttribute((const void*)trunk_fwd, hipFuncAttributeMaxDynamicSharedMemorySize, LDS_BYTES) != hipSuccess) { fprintf(stderr, "kernel_launch: hipFuncSetAttribute failed\n"); grid = -1; return; }
        if (hipOccupancyMaxActiveBlocksPerMultiprocessor(&per_cu, (const void*)trunk_fwd, NTHR, LDS_BYTES) != hipSuccess || per_cu < 1) { fprintf(stderr, "kernel_launch: occupancy query says %d\n", per_cu); per_cu = 1; }
        (void)hipGetLastError();
        grid = cus * 1;
    }
    if (grid < 0) return;
    if (hipMemsetAsync(d_ws, 0, 16384, stream) != hipSuccess) { fprintf(stderr, "kernel_launch: memset failed\n"); return; }
    Args a{};
    for (int i = 0; i < 14; ++i) a.in[i] = (const float*)d_in[i];
    a.out = (float*)d_out; a.ws = (unsigned char*)d_ws;
#if MK_SINGLE
    a.ph_lo = 0; a.ph_hi = NPH;
    void* kargs[] = {&a};
    hipError_t e = hipLaunchCooperativeKernel((const void*)trunk_fwd, dim3(grid), dim3(NTHR), kargs, LDS_BYTES, stream);
    if (e != hipSuccess) fprintf(stderr, "kernel_launch: cooperative launch failed: %s (grid %d)\n", hipGetErrorString(e), grid);
#else
    for (int p = 0; p < NPH; ++p) { a.ph_lo = p; a.ph_hi = p + 1; hipLaunchKernelGGL(trunk_fwd, dim3(grid), dim3(NTHR), LDS_BYTES, stream, a); }
#endif
}
```

```cpp
#include <hip/hip_runtime.h>
#include <hip/hip_cooperative_groups.h>
#include <cstdio>
#include <cstdint>
namespace cg = cooperative_groups;
#ifndef MK_SINGLE
#define MK_SINGLE 1
#endif
namespace pg8 {
#define PG8_LAS __attribute__((address_space(3)))
typedef unsigned short bf16_t;
typedef short bf16x8 __attribute__((ext_vector_type(8)));
typedef float f32x4 __attribute__((ext_vector_type(4)));
typedef unsigned u32x4 __attribute__((ext_vector_type(4)));
constexpr int BM = 256, BK = 64, HALF = 128, HTB = HALF * BK * 2  , STAGE_BYTES = 8 * HTB, NXCD = 8, WGM = 8;

__host__ __device__ __forceinline__ int lds_byte(int r, int c) { const int st = (r >> 4) * 2 + (c >> 5), rr = r & 15, cc = c & 31, ob = rr * 64 + cc * 2; return st * 1024 + (ob ^ (((ob >> 9) & 1) << 5)); }
__host__ __device__ __forceinline__ void stage_rc(int b, int& R, int& C) { const int st = b / 1024, sb = b % 1024, swz = sb ^ (((sb >> 9) & 1) << 5); R = (st >> 1) * 16 + swz / 64; C = (st & 1) * 32 + (swz % 64) / 2; }
__host__ __device__ __forceinline__ int perm32(int rho) { const int n = rho >> 4, i = rho & 15; return 8 * (i >> 2) + 4 * n + (i & 3); }

struct Unit { int pm, pn; };
struct Gemm { const bf16_t* A; const bf16_t* Bt; int M, N, K; };

struct StaticOrder {
    int nM, nN, nwg, G, c;
    __host__ __device__ void init(int M, int N, int G_, int c_) { nM = M / BM; nN = N / BM; nwg = nM * nN; G = G_; c = c_; }
    __host__ __device__ bool next(int i, Unit& u) const {
        const long L = (long)i * G + c; if (L >= nwg) return false;
        int wgid = (int)L; { const int q = nwg / NXCD, r = nwg % NXCD, xcd = wgid % NXCD, off = wgid / NXCD; wgid = (xcd < r ? xcd * (q + 1) : r * (q + 1) + (xcd - r) * q) + off; }
        const int nig = WGM * nN, gid = wgid / nig, fm = gid * WGM, gsz = (nM - fm) < WGM ? (nM - fm) : WGM;
        u.pm = fm + ((wgid % nig) % gsz); u.pn = (wgid % nig) / gsz; return true;
    }
    __device__ __forceinline__ void a_ready(const Unit&) const {}
    __device__ __forceinline__ void done(const Unit&) const {}
};
__device__ __forceinline__ unsigned cvt_pk_bf16(float lo, float hi) { unsigned r; asm volatile("v_cvt_pk_bf16_f32 %0, %1, %2" : "=v"(r) : "v"(lo), "v"(hi)); return r; }
typedef float f32x2 __attribute__((ext_vector_type(2)));
typedef unsigned u32x2 __attribute__((ext_vector_type(2)));
__device__ __forceinline__ float ror1(float v) { return __int_as_float(__builtin_amdgcn_update_dpp(0, __float_as_int(v), 0x121, 0xf, 0xf, true)); }
__device__ __forceinline__ float ror2(float v) { return __int_as_float(__builtin_amdgcn_update_dpp(0, __float_as_int(v), 0x122, 0xf, 0xf, true)); }
template <int K_> __device__ __forceinline__ float shr_dpp(float v) { return __int_as_float(__builtin_amdgcn_update_dpp(0, __float_as_int(v), 0x110 + K_, 0xf, 0xf, true)); }
__device__ __forceinline__ float bc15_dpp(float v) { return __int_as_float(__builtin_amdgcn_update_dpp(0, __float_as_int(v), 0x15F, 0xf, 0xf, false)); }
template <int K_> __device__ __forceinline__ float shr_keep(float old, float v) { return __int_as_float(__builtin_amdgcn_update_dpp(__float_as_int(old), __float_as_int(v), 0x110 + K_, 0xf, 0xf, false)); }
template <int mode, int KC_> struct Epi {
    static constexpr bool PERM = true, AFTER_DRAIN = false; static constexpr int KC = KC_;
    bf16_t* O; int ldc; const float* ssp_in;
    bf16_t* Ub; const float* cw;
    bf16_t* hb; float* ssp_out;
    const bf16_t* resb;
    float* out; const float* res; const float* ss;
    bf16_t* Q; float* LOGF; bf16_t* V; bf16_t* G; const float* lbt;
    bf16_t* KE;
    __device__ __forceinline__ void operator()(const f32x4 (&acc)[2][2][4][2], const Unit& u, int wr, int wc, int fr_, int fq_) const {
        int l_; asm volatile("v_mbcnt_lo_u32_b32 %0, -1, 0\n\tv_mbcnt_hi_u32_b32 %0, -1, %0" : "=v"(l_));
        const int fr = l_ & 15, fq = l_ >> 4; (void)fr_; (void)fq_;
        const int row0 = u.pm * BM + wr * 64 + fr;
        if constexpr (mode == 0) {
            const int col0 = u.pn * BM + wc * 32 + 8 * fq;
            float rs[2][4];
#pragma unroll
            for (int ai = 0; ai < 2; ++ai)
#pragma unroll
                for (int m = 0; m < 4; ++m) rs[ai][m] = ssp_in ? ssp_in[row0 + ai * HALF + m * 16] : 1.0f;
            if (ssp_in) {
#pragma unroll
                for (int ai = 0; ai < 2; ++ai)
#pragma unroll
                    for (int m = 0; m < 4; ++m) rs[ai][m] = __builtin_amdgcn_rsqf(rs[ai][m] * (1.0f / 2048.0f) + 1e-6f); }
#pragma unroll
            for (int ai = 0; ai < 2; ++ai)
#pragma unroll
                for (int m = 0; m < 4; ++m) { const int row = row0 + ai * HALF + m * 16; bf16_t* rowp = O + (size_t)row * ldc + col0;
#pragma unroll
                    for (int bj = 0; bj < 2; ++bj) { const f32x4 v0 = acc[ai][bj][m][0] * rs[ai][m], v1 = acc[ai][bj][m][1] * rs[ai][m];
                        u32x4 w; w.x = cvt_pk_bf16(v0[0], v0[1]); w.y = cvt_pk_bf16(v0[2], v0[3]); w.z = cvt_pk_bf16(v1[0], v1[1]); w.w = cvt_pk_bf16(v1[2], v1[3]);
                        *(u32x4*)(rowp + bj * HALF) = w; } }
        } else if constexpr (mode == 1) {
            const int col0 = u.pn * BM + wc * 32 + 8 * fq;
            float sc8[2][4];
#pragma unroll
            for (int ai = 0; ai < 2; ++ai)
#pragma unroll
                for (int m = 0; m < 4; ++m) sc8[ai][m] = ss ? ss[row0 + ai * HALF + m * 16] : 1.0f;
            if (ss) {
#pragma unroll
                for (int ai = 0; ai < 2; ++ai)
#pragma unroll
                    for (int m = 0; m < 4; ++m) sc8[ai][m] = __builtin_amdgcn_rsqf(sc8[ai][m] * (1.0f / 2048.0f) + 1e-6f); }
#pragma unroll
            for (int ai = 0; ai < 2; ++ai)
#pragma unroll
                for (int m = 0; m < 4; ++m) { const int row = row0 + ai * HALF + m * 16; const size_t off = (size_t)row * 2048 + col0;
                    const float sc = sc8[ai][m];
                    float ssq = 0.f;
#pragma unroll
                    for (int bj = 0; bj < 2; ++bj) { f32x4 r0, r1;
                        if (resb) { const u32x4 rw = *(const u32x4*)(resb + off + bj * HALF);
                            r0 = (f32x4){__uint_as_float(rw.x << 16), __uint_as_float(rw.x & 0xffff0000u), __uint_as_float(rw.y << 16), __uint_as_float(rw.y & 0xffff0000u)};
                            r1 = (f32x4){__uint_as_float(rw.z << 16), __uint_as_float(rw.z & 0xffff0000u), __uint_as_float(rw.w << 16), __uint_as_float(rw.w & 0xffff0000u)}; }
                        else { r0 = *(const f32x4*)(res + off + bj * HALF); r1 = *(const f32x4*)(res + off + bj * HALF + 4); }
                        const f32x4 o0 = r0 + acc[ai][bj][m][0] * sc, o1 = r1 + acc[ai][bj][m][1] * sc;
                        if (out) { *(f32x4*)(out + off + bj * HALF) = o0; *(f32x4*)(out + off + bj * HALF + 4) = o1; }
                        ssq += ((o0[0] * o0[0] + o0[1] * o0[1]) + (o0[2] * o0[2] + o0[3] * o0[3])) + ((o1[0] * o1[0] + o1[1] * o1[1]) + (o1[2] * o1[2] + o1[3] * o1[3]));
                        if (hb) { u32x4 w; w.x = cvt_pk_bf16(o0[0], o0[1]); w.y = cvt_pk_bf16(o0[2], o0[3]); w.z = cvt_pk_bf16(o1[0], o1[1]); w.w = cvt_pk_bf16(o1[2], o1[3]); *(u32x4*)(hb + off + bj * HALF) = w; } }
                    if (ssp_out) { ssq += __shfl_xor(ssq, 16); ssq += __shfl_xor(ssq, 32); if (fq == 0) unsafeAtomicAdd(ssp_out + row, ssq); }
                    asm volatile("" ::: "memory"); }
        } else if constexpr (mode == 3) {
            const int cbase = u.pn * 128 + wc * 32 + 8 * fq;
            f32x4 WG[2][3], WV[2][3]; float rsa[2][4];
#pragma unroll
            for (int n = 0; n < 2; ++n)
#pragma unroll
                for (int k = 0; k < 3; ++k) { WG[n][k] = *(const f32x4*)(cw + k * 11264 + cbase + 4 * n); WV[n][k] = *(const f32x4*)(cw + k * 11264 + 5632 + cbase + 4 * n); }
#pragma unroll
            for (int ai = 0; ai < 2; ++ai)
#pragma unroll
                for (int m = 0; m < 4; ++m) rsa[ai][m] = ssp_in[row0 + ai * HALF + m * 16];
#pragma unroll
            for (int ai = 0; ai < 2; ++ai) {
                float rs[4];
#pragma unroll
                for (int m = 0; m < 4; ++m) rs[m] = __builtin_amdgcn_rsqf(rsa[ai][m] * (1.0f / 2048.0f) + 1e-6f);
                unsigned op[2][4][2];
#pragma unroll
                for (int n = 0; n < 2; ++n) {
                    const f32x4 wg0 = WG[n][0], wg1 = WG[n][1], wg2 = WG[n][2], wv0 = WV[n][0], wv1 = WV[n][1], wv2 = WV[n][2];
#pragma unroll
                    for (int jp = 0; jp < 2; ++jp) {
                        const f32x2 g0 = {wg0[2 * jp], wg0[2 * jp + 1]}, g1 = {wg1[2 * jp], wg1[2 * jp + 1]}, g2 = {wg2[2 * jp], wg2[2 * jp + 1]};
                        const f32x2 h0 = {wv0[2 * jp], wv0[2 * jp + 1]}, h1 = {wv1[2 * jp], wv1[2 * jp + 1]}, h2 = {wv2[2 * jp], wv2[2 * jp + 1]};
                        f32x2 cg[4], cv[4];
                        { f32x2 x[4];
#pragma unroll
                          for (int m = 0; m < 4; ++m) x[m] = (f32x2){acc[ai][0][m][n][2 * jp], acc[ai][0][m][n][2 * jp + 1]} * rs[m];
                          f32x2 q1 = {0.f, 0.f}, q2 = {0.f, 0.f};
#pragma unroll
                          for (int m = 0; m < 4; ++m) { f32x2 x1, x2; x1.x = shr_keep<1>(q1.x, x[m].x); x1.y = shr_keep<1>(q1.y, x[m].y); x2.x = shr_keep<2>(q2.x, x[m].x); x2.y = shr_keep<2>(q2.y, x[m].y);
                              cg[m] = g0 * x2 + g1 * x1 + g2 * x[m]; if (m < 3) { q1.x = ror1(x[m].x); q1.y = ror1(x[m].y); q2.x = ror2(x[m].x); q2.y = ror2(x[m].y); } } }
                        { f32x2 y[4];
#pragma unroll
                          for (int m = 0; m < 4; ++m) y[m] = (f32x2){acc[ai][1][m][n][2 * jp], acc[ai][1][m][n][2 * jp + 1]} * rs[m];
                          f32x2 q1 = {0.f, 0.f}, q2 = {0.f, 0.f};
#pragma unroll
                          for (int m = 0; m < 4; ++m) { f32x2 y1, y2; y1.x = shr_keep<1>(q1.x, y[m].x); y1.y = shr_keep<1>(q1.y, y[m].y); y2.x = shr_keep<2>(q2.x, y[m].x); y2.y = shr_keep<2>(q2.y, y[m].y);
                              cv[m] = h0 * y2 + h1 * y1 + h2 * y[m]; if (m < 3) { q1.x = ror1(y[m].x); q1.y = ror1(y[m].y); q2.x = ror2(y[m].x); q2.y = ror2(y[m].y); } } }
#pragma unroll
                        for (int m = 0; m < 4; ++m) { f32x2 sg; sg.x = __builtin_amdgcn_rcpf(1.0f + __expf(-cg[m].x)); sg.y = __builtin_amdgcn_rcpf(1.0f + __expf(-cg[m].y));
                            const f32x2 o = cg[m] * sg * cv[m]; op[n][m][jp] = cvt_pk_bf16(o.x, o.y); }
                        __builtin_amdgcn_sched_barrier(0);
                    }
                }
#pragma unroll
                for (int m = 0; m < 4; ++m) { const size_t row = (size_t)(row0 + ai * HALF + m * 16);
                    if (m > 0 || fr >= 2) { u32x4 w; w.x = op[0][m][0]; w.y = op[0][m][1]; w.z = op[1][m][0]; w.w = op[1][m][1]; *(u32x4*)(O + row * 5632 + cbase) = w; }
                    if ((m == 0 && fr < 2) || (m == 3 && fr >= 14)) { const f32x4 xg0 = acc[ai][0][m][0] * rs[m], xg1 = acc[ai][0][m][1] * rs[m], yv0 = acc[ai][1][m][0] * rs[m], yv1 = acc[ai][1][m][1] * rs[m];
                        u32x4 w; w.x = cvt_pk_bf16(xg0[0], xg0[1]); w.y = cvt_pk_bf16(xg0[2], xg0[3]); w.z = cvt_pk_bf16(xg1[0], xg1[1]); w.w = cvt_pk_bf16(xg1[2], xg1[3]); *(u32x4*)(Ub + row * 11264 + cbase) = w;
                        w.x = cvt_pk_bf16(yv0[0], yv0[1]); w.y = cvt_pk_bf16(yv0[2], yv0[3]); w.z = cvt_pk_bf16(yv1[0], yv1[1]); w.w = cvt_pk_bf16(yv1[2], yv1[3]); *(u32x4*)(Ub + row * 11264 + 5632 + cbase) = w; } }
                __builtin_amdgcn_sched_barrier(0);
            }
        } else if constexpr (mode == 4) {
            if (u.pn & 4) {
                const int t = 16 + (u.pn >> 3) * 4 + (u.pn & 3); const bool isv = t < 24; bf16_t* base = isv ? V : G; const int col0 = ((t - 16) & 7) * BM + wc * 32 + 8 * fq;
#pragma unroll
                for (int ai = 0; ai < 2; ++ai)
#pragma unroll
                    for (int m = 0; m < 4; ++m) { bf16_t* rowp = base + (size_t)(row0 + ai * HALF + m * 16) * 2048 + col0;
#pragma unroll
                        for (int bj = 0; bj < 2; ++bj) { f32x4 v0 = acc[ai][bj][m][0], v1 = acc[ai][bj][m][1];
                            if (!isv) {
#pragma unroll
                                for (int j = 0; j < 4; ++j) { v0[j] = v0[j] * __builtin_amdgcn_rcpf(1.0f + __expf(-v0[j])); v1[j] = v1[j] * __builtin_amdgcn_rcpf(1.0f + __expf(-v1[j])); } }
                            u32x4 w; w.x = cvt_pk_bf16(v0[0], v0[1]); w.y = cvt_pk_bf16(v0[2], v0[3]); w.z = cvt_pk_bf16(v1[0], v1[1]); w.w = cvt_pk_bf16(v1[2], v1[3]);
                            *(u32x4*)(rowp + bj * HALF) = w; } }
            } else {
                const int h = (u.pn >> 3) * 4 + (u.pn & 3), cl = wc * 32 + 8 * fq;
                f32x4 lb[2];
#pragma unroll
                for (int n = 0; n < 2; ++n) { const float* p = lbt + h * 128 + cl + 4 * n; const f32x4 t0 = *(const f32x4*)p, t1 = *(const f32x4*)(p + 2048), t2 = *(const f32x4*)(p + 4096);
#pragma unroll
                    for (int j = 0; j < 4; ++j) { const float mx = fmaxf(t0[j], fmaxf(t1[j], t2[j])); const float e0 = __expf(t0[j] - mx), e1 = __expf(t1[j] - mx), e2 = __expf(t2[j] - mx); lb[n][j] = e0 / (e0 + e1 + e2); } }
#pragma unroll
                for (int ai = 0; ai < 2; ++ai) {
                    const int m0 = u.pm * BM + ai * HALF + wr * 64;
                    const int task = ((m0 >> 12) * 16 + h) * 64 + ((m0 & 4095) >> 6);
                    unsigned qp[2][4][2], kp[2][4][2];
#pragma unroll
                    for (int n = 0; n < 2; ++n) {
                        f32x4 er, ebr, dec;
#pragma unroll
                        for (int jp = 0; jp < 2; ++jp) {
                            float qo[4][2], ko[4][2];
#pragma unroll
                            for (int e = 0; e < 2; ++e) { const int j = jp * 2 + e; const float l = lb[n][j];
                                float kk[4], bb[4];
#pragma unroll
                                for (int m = 0; m < 4; ++m) { const float a = acc[ai][1][m][n][j]; const float sg = __builtin_amdgcn_rcpf(1.0f + __expf(-a)); const float f = l + (1.0f - l) * sg; kk[m] = 1.0f - f;
                                    float s = __builtin_amdgcn_logf(f) * 0.6931471805599453f;     s += shr_dpp<1>(s); s += shr_dpp<2>(s); s += shr_dpp<4>(s); s += shr_dpp<8>(s); bb[m] = s; }
                                const float t0 = bc15_dpp(bb[0]), t1 = bc15_dpp(bb[1]), t2 = bc15_dpp(bb[2]), t3 = bc15_dpp(bb[3]);
                                const float c1 = t0 + t1; bb[1] += t0; bb[2] += c1; bb[3] += c1 + t2; const float bl = (c1 + t2) + t3;
                                const float r = c1;
#pragma unroll
                                for (int m = 0; m < 4; ++m) { const float aq = acc[ai][0][m][n][j]; const float qv = aq * __builtin_amdgcn_rcpf(1.0f + __expf(-aq)) * 0.08838834764831845f; const float e1 = __expf(bb[m] - r);
                                    qo[m][e] = qv * e1; ko[m][e] = kk[m] * __builtin_amdgcn_rcpf(e1); }
                                er[j] = __expf(r); ebr[j] = __expf(bl - r); dec[j] = __expf(bl);
                            }
#pragma unroll
                            for (int m = 0; m < 4; ++m) { qp[n][m][jp] = cvt_pk_bf16(qo[m][0], qo[m][1]); kp[n][m][jp] = cvt_pk_bf16(ko[m][0], ko[m][1]); }
                        }
                        if (fr == 0) { float* vp = LOGF + (size_t)task * 128 + cl + 4 * n; *(f32x4*)vp = er; *(f32x4*)(vp + 2048 * 128) = ebr; *(f32x4*)(vp + 2 * 2048 * 128) = dec; }
                        __builtin_amdgcn_sched_barrier(0);
                    }
#pragma unroll
                    for (int m = 0; m < 4; ++m) { const size_t off = (size_t)(row0 + ai * HALF + m * 16) * 2048 + h * 128 + cl;
                        u32x4 w; w.x = qp[0][m][0]; w.y = qp[0][m][1]; w.z = qp[1][m][0]; w.w = qp[1][m][1]; *(u32x4*)(Q + off) = w;
                        w.x = kp[0][m][0]; w.y = kp[0][m][1]; w.z = kp[1][m][0]; w.w = kp[1][m][1]; *(u32x4*)(KE + off) = w; }
                }
            }
        } else {
            const int sec = u.pn >> 3, col0 = (u.pn & 7) * BM + wc * 32 + 8 * fq;
            if (sec == 2) {
#pragma unroll
                for (int ai = 0; ai < 2; ++ai)
#pragma unroll
                    for (int m = 0; m < 4; ++m) { bf16_t* rowp = V + (size_t)(row0 + ai * HALF + m * 16) * 2048 + col0;
#pragma unroll
                        for (int bj = 0; bj < 2; ++bj) { const f32x4 v0 = acc[ai][bj][m][0], v1 = acc[ai][bj][m][1];
                            u32x4 w; w.x = cvt_pk_bf16(v0[0], v0[1]); w.y = cvt_pk_bf16(v0[2], v0[3]); w.z = cvt_pk_bf16(v1[0], v1[1]); w.w = cvt_pk_bf16(v1[2], v1[3]);
                            *(u32x4*)(rowp + bj * HALF) = w; } }
            } else if (sec == 1) {
                f32x4 lb[2][2];
#pragma unroll
                for (int bj = 0; bj < 2; ++bj)
#pragma unroll
                    for (int n = 0; n < 2; ++n) { const float* p = lbt + col0 + bj * HALF + 4 * n; const f32x4 t0 = *(const f32x4*)p, t1 = *(const f32x4*)(p + 2048), t2 = *(const f32x4*)(p + 4096);
#pragma unroll
                        for (int j = 0; j < 4; ++j) { const float mx = fmaxf(t0[j], fmaxf(t1[j], t2[j])); const float e0 = __expf(t0[j] - mx), e1 = __expf(t1[j] - mx), e2 = __expf(t2[j] - mx); lb[bj][n][j] = e0 / (e0 + e1 + e2); } }
#pragma unroll
                for (int ai = 0; ai < 2; ++ai)
#pragma unroll
                    for (int m = 0; m < 4; ++m) { float* rowp = LOGF + (size_t)(row0 + ai * HALF + m * 16) * 2048 + col0;
#pragma unroll
                        for (int bj = 0; bj < 2; ++bj)
#pragma unroll
                            for (int n = 0; n < 2; ++n) { f32x4 o;
#pragma unroll
                                for (int j = 0; j < 4; ++j) { const float a = acc[ai][bj][m][n][j]; const float sg = __builtin_amdgcn_rcpf(1.0f + __expf(-a)); const float l = lb[bj][n][j]; o[j] = __logf(l + (1.0f - l) * sg); }
                                *(f32x4*)(rowp + bj * HALF + 4 * n) = o; } }
            } else {
                bf16_t* base = sec == 0 ? Q : G; const float sc = sec == 0 ? 0.08838834764831845f : 1.0f;
#pragma unroll
                for (int ai = 0; ai < 2; ++ai)
#pragma unroll
                    for (int m = 0; m < 4; ++m) { bf16_t* rowp = base + (size_t)(row0 + ai * HALF + m * 16) * 2048 + col0;
#pragma unroll
                        for (int bj = 0; bj < 2; ++bj) { f32x4 v0 = acc[ai][bj][m][0], v1 = acc[ai][bj][m][1];
#pragma unroll
                            for (int j = 0; j < 4; ++j) { v0[j] = v0[j] * sc * __builtin_amdgcn_rcpf(1.0f + __expf(-v0[j])); v1[j] = v1[j] * sc * __builtin_amdgcn_rcpf(1.0f + __expf(-v1[j])); }
                            u32x4 w; w.x = cvt_pk_bf16(v0[0], v0[1]); w.y = cvt_pk_bf16(v0[2], v0[3]); w.z = cvt_pk_bf16(v1[0], v1[1]); w.w = cvt_pk_bf16(v1[2], v1[3]);
                            *(u32x4*)(rowp + bj * HALF) = w; } }
            }
        }
    }
};

template <class Epi, class Sched, bool ALIGN_EPI = false, bool SP2 = false>
__device__ __forceinline__ void gemm_phase(PG8_LAS unsigned char* lds, const Gemm g, const Sched& S, const Epi& E, const int wid) {
    int lane_; asm volatile("v_mbcnt_lo_u32_b32 %0, -1, 0\n\tv_mbcnt_hi_u32_b32 %0, -1, %0" : "=v"(lane_));
    const int lane = lane_, tid = wid * 64 + lane, wr = wid >> 2, wc = wid & 3, fr = lane & 15, fq = lane >> 4;
    constexpr int K = Epi::KC, nt = K / BK;
    unsigned voffA[2], voffB[2];
#pragma unroll
    for (int i = 0; i < 2; ++i) { int R, C; stage_rc(tid * 16 + i * 8192, R, C); const int Rb = Epi::PERM ? ((R & ~31) + perm32(R & 31)) : R;
        voffA[i] = (unsigned)(R * K + C) * 2u; voffB[i] = (unsigned)(Rb * K + C) * 2u; }
    const size_t kstep = (size_t)(BK * 2);
    const size_t hstep = (size_t)HALF * K * 2;
    const size_t tstep = 2 * hstep;
    const unsigned ldsw = (unsigned)wid * 1024u;
    const int aoff = lds_byte(wr * 64 + fr, fq * 8), boff = lds_byte(wc * 32 + fr, fq * 8);
#define PG8_SA(b, h) (((b) * 2 + (h)) * HTB)
#define PG8_SB(b, h) ((4 + (b) * 2 + (h)) * HTB)
#define PG8_STAGE(bufoff, gbase, voff) do { _Pragma("unroll") for (int _i = 0; _i < 2; ++_i) \
        __builtin_amdgcn_global_load_lds((const unsigned*)((const char*)(gbase) + (voff)[_i]), (PG8_LAS unsigned*)(lds + (bufoff) + ldsw + _i * 8192), 16, 0, 0); } while (0)
#define PG8_LDA(dst, b, h) do { _Pragma("unroll") for (int m = 0; m < 4; ++m) _Pragma("unroll") for (int k = 0; k < 2; ++k) dst[m][k] = *(const PG8_LAS bf16x8*)(lds + PG8_SA(b, h) + aoff + m * 2048 + k * 1024); } while (0)
#define PG8_LDB(dst, b, h) do { _Pragma("unroll") for (int n = 0; n < 2; ++n) _Pragma("unroll") for (int k = 0; k < 2; ++k) dst[n][k] = *(const PG8_LAS bf16x8*)(lds + PG8_SB(b, h) + boff + n * 2048 + k * 1024); } while (0)
#define PG8_MMA(ai, bj, At, Bt) do { __builtin_amdgcn_s_setprio(1); _Pragma("unroll") for (int m = 0; m < 4; ++m) _Pragma("unroll") for (int n = 0; n < 2; ++n) _Pragma("unroll") for (int k = 0; k < 2; ++k) \
        acc[ai][bj][m][n] = __builtin_amdgcn_mfma_f32_16x16x32_bf16(Bt[n][k], At[m][k], acc[ai][bj][m][n], 0, 0, 0); __builtin_amdgcn_s_setprio(0); } while (0)
#define PG8_WAIT_V(n) asm volatile("s_waitcnt vmcnt(" #n ")" ::: "memory")
#define PG8_WAIT_L(n) asm volatile("s_waitcnt lgkmcnt(" #n ")" ::: "memory")
#define PG8_BAR __builtin_amdgcn_s_barrier()
#define PG8_SCHED __builtin_amdgcn_sched_barrier(0)
    Unit cur, nxt; int ui = 0;
    if (!S.next(0, cur)) return;
    f32x4 acc[2][2][4][2];
#pragma unroll
    for (int a = 0; a < 2; ++a)
#pragma unroll
        for (int b = 0; b < 2; ++b)
#pragma unroll
            for (int m = 0; m < 4; ++m)
#pragma unroll
                for (int n = 0; n < 2; ++n) acc[a][b][m][n] = (f32x4){0.f, 0.f, 0.f, 0.f};
    bf16x8 At[4][2], B0[2][2], B1[2][2];
    const char* cA = (const char*)g.A + (size_t)cur.pm * tstep; const char* cB = (const char*)g.Bt + (size_t)cur.pn * tstep;
    S.a_ready(cur);
    if constexpr (SP2) {
        PG8_STAGE(PG8_SB(0, 0), cB, voffB); PG8_STAGE(PG8_SB(0, 1), cB + hstep, voffB); PG8_STAGE(PG8_SA(0, 0), cA, voffA); PG8_STAGE(PG8_SA(0, 1), cA + hstep, voffA);
        if (wr == 1) PG8_BAR;
        PG8_WAIT_V(2); PG8_BAR;
        PG8_STAGE(PG8_SB(1, 0), cB + kstep, voffB); PG8_STAGE(PG8_SA(1, 0), cA + kstep, voffA); PG8_STAGE(PG8_SB(1, 1), cB + hstep + kstep, voffB);
        PG8_WAIT_V(6); PG8_BAR;
    } else {
        PG8_STAGE(PG8_SB(0, 0), cB, voffB); PG8_STAGE(PG8_SA(0, 0), cA, voffA); PG8_STAGE(PG8_SB(0, 1), cB + hstep, voffB); PG8_STAGE(PG8_SA(0, 1), cA + hstep, voffA);
        if (wr == 1) PG8_BAR;
        PG8_WAIT_V(4); PG8_BAR;
        PG8_STAGE(PG8_SB(1, 0), cB + kstep, voffB); PG8_STAGE(PG8_SA(1, 0), cA + kstep, voffA); PG8_STAGE(PG8_SB(1, 1), cB + hstep + kstep, voffB);
        PG8_WAIT_V(6); PG8_BAR;
    }
    for (;;) {
        const bool has_next = S.next(ui + 1, nxt);
        const char* nA = has_next ? (const char*)g.A + (size_t)nxt.pm * tstep : cA; const char* nB = has_next ? (const char*)g.Bt + (size_t)nxt.pn * tstep : cB;
        for (int t = 0; t < nt; t += 2) {
            const bool last = (t == nt - 2);
            const char* a1 = cA + (size_t)(t + 1) * kstep;
            const char* a2 = last ? nA : cA + (size_t)(t + 2) * kstep; const char* b2 = last ? nB : cB + (size_t)(t + 2) * kstep;
            const char* a3 = a2 + kstep; const char* b3 = b2 + kstep;
            if (last && has_next) S.a_ready(nxt);
            if constexpr (SP2) {
            PG8_LDB(B0, 0, 0); PG8_LDB(B1, 0, 1); PG8_SCHED; PG8_LDA(At, 0, 0); PG8_STAGE(PG8_SA(1, 1), a1 + hstep, voffA);
            PG8_WAIT_V(8); PG8_WAIT_L(0); PG8_BAR; PG8_MMA(0, 0, At, B0); PG8_MMA(0, 1, At, B1); PG8_BAR; PG8_SCHED;
            PG8_LDA(At, 0, 1); PG8_STAGE(PG8_SB(0, 0), b2, voffB); PG8_STAGE(PG8_SB(0, 1), b2 + hstep, voffB); PG8_STAGE(PG8_SA(0, 0), a2, voffA);
            PG8_WAIT_V(8); PG8_WAIT_L(0); PG8_BAR; PG8_MMA(1, 0, At, B0); PG8_MMA(1, 1, At, B1); PG8_BAR; PG8_SCHED;
            PG8_LDB(B0, 1, 0); PG8_LDB(B1, 1, 1); PG8_SCHED; PG8_LDA(At, 1, 0); PG8_STAGE(PG8_SA(0, 1), a2 + hstep, voffA);
            PG8_WAIT_V(8); PG8_WAIT_L(0); PG8_BAR; PG8_MMA(0, 0, At, B0); PG8_MMA(0, 1, At, B1); PG8_BAR; PG8_SCHED;
            PG8_LDA(At, 1, 1); PG8_STAGE(PG8_SB(1, 0), b3, voffB); PG8_STAGE(PG8_SB(1, 1), b3 + hstep, voffB); PG8_STAGE(PG8_SA(1, 0), a3, voffA);
            PG8_WAIT_V(8); PG8_WAIT_L(0); PG8_BAR; PG8_MMA(1, 0, At, B0); PG8_MMA(1, 1, At, B1); PG8_BAR; PG8_SCHED;
            } else {
            PG8_LDB(B0, 0, 0); PG8_SCHED; PG8_LDA(At, 0, 0); PG8_STAGE(PG8_SA(1, 1), a1 + hstep, voffA);
            PG8_WAIT_L(8); PG8_BAR; PG8_WAIT_L(0); PG8_MMA(0, 0, At, B0); PG8_BAR; PG8_SCHED;
            PG8_LDB(B1, 0, 1); PG8_STAGE(PG8_SB(0, 0), b2, voffB);
            PG8_BAR; PG8_WAIT_L(0); PG8_MMA(0, 1, At, B1); PG8_BAR;
            PG8_LDA(At, 0, 1); PG8_STAGE(PG8_SA(0, 0), a2, voffA);
            PG8_BAR; PG8_WAIT_L(0); PG8_MMA(1, 0, At, B0); PG8_BAR; PG8_SCHED;
            PG8_STAGE(PG8_SB(0, 1), b2 + hstep, voffB);
            PG8_WAIT_V(6); PG8_BAR; PG8_MMA(1, 1, At, B1); PG8_BAR;
            PG8_LDB(B0, 1, 0); PG8_SCHED; PG8_LDA(At, 1, 0); PG8_STAGE(PG8_SA(0, 1), a2 + hstep, voffA);
            PG8_WAIT_L(8); PG8_BAR; PG8_WAIT_L(0); PG8_MMA(0, 0, At, B0); PG8_BAR; PG8_SCHED;
            PG8_LDB(B1, 1, 1); PG8_STAGE(PG8_SB(1, 0), b3, voffB);
            PG8_BAR; PG8_WAIT_L(0); PG8_MMA(0, 1, At, B1); PG8_BAR;
            PG8_LDA(At, 1, 1); PG8_STAGE(PG8_SA(1, 0), a3, voffA);
            PG8_BAR; PG8_WAIT_L(0); PG8_MMA(1, 0, At, B0); PG8_BAR; PG8_SCHED;
            PG8_STAGE(PG8_SB(1, 1), b3 + hstep, voffB);
            PG8_WAIT_V(6); PG8_BAR; PG8_MMA(1, 1, At, B1); PG8_BAR;
            }
        }
        if constexpr (ALIGN_EPI) { if (wr == 0) PG8_BAR; }
        if constexpr (!Epi::AFTER_DRAIN) { E(acc, cur, wr, wc, fr, fq); S.done(cur); }
        if (!has_next) break;
#pragma unroll
        for (int a = 0; a < 2; ++a)
#pragma unroll
            for (int b = 0; b < 2; ++b)
#pragma unroll
                for (int m = 0; m < 4; ++m)
#pragma unroll
                    for (int n = 0; n < 2; ++n) acc[a][b][m][n] = (f32x4){0.f, 0.f, 0.f, 0.f};
        cur = nxt; cA = nA; cB = nB; ++ui;
        if constexpr (ALIGN_EPI) { if (wr == 1) PG8_BAR; }
    }
    PG8_WAIT_V(0);
    if constexpr (!ALIGN_EPI) { if (wr == 0) PG8_BAR; }
    PG8_BAR;
    if constexpr (Epi::AFTER_DRAIN) { E.fused(acc, cur, wr, wc, fr, fq, lds, wid, lane); S.done(cur); }
#undef PG8_SA
#undef PG8_SB
#undef PG8_STAGE
#undef PG8_LDA
#undef PG8_LDB
#undef PG8_MMA
#undef PG8_WAIT_V
#undef PG8_WAIT_L
#undef PG8_BAR
#undef PG8_SCHED
}
}

#define LAS __attribute__((address_space(3)))
typedef unsigned short bf16;
typedef short bf16x8 __attribute__((ext_vector_type(8)));
typedef float f32x4 __attribute__((ext_vector_type(4)));
typedef unsigned u32x4 __attribute__((ext_vector_type(4)));
typedef unsigned u32x2 __attribute__((ext_vector_type(2)));
constexpr int NWAVES = 8, NTHR = 512;
constexpr int SEQ = 4096, D = 2048, M = 8192, HD = 128, FF = 5632, NIN = 8192, NSC = 6144, NUP = 11264;
constexpr int NTASK = 2048;
constexpr float EPS = 1e-6f;
constexpr int LDS_BYTES = 147456;

constexpr size_t MiB = 1u << 20;
constexpr size_t WS_WIN = 1 * MiB, WS_WOH = WS_WIN + 32 * MiB, WS_WUP0 = WS_WOH + 8 * MiB, WS_WUP1 = WS_WUP0 + 44 * MiB, WS_WDN0 = WS_WUP1 + 44 * MiB, WS_WDN1 = WS_WDN0 + 22 * MiB,
                 WS_WSI = WS_WDN1 + 22 * MiB, WS_WSO = WS_WSI + 24 * MiB, WS_XN = WS_WSO + 8 * MiB, WS_R = WS_XN + 32 * MiB;
constexpr size_t WS_Q = WS_R, WS_LOGF = WS_Q + 32 * MiB  , WS_V = WS_LOGF + 64 * MiB  , WS_G = WS_V + 32 * MiB, WS_UT = WS_G + 32 * MiB, WS_SP = WS_UT + 128 * MiB,
                 WS_DEC = WS_SP + 64 * MiB, WS_SS = WS_DEC + 1 * MiB, WS_R_END = WS_SS + 1 * MiB;
constexpr size_t WS_U = WS_R, WS_ACT = WS_U + 176 * MiB;
constexpr size_t WS_P2 = WS_R, WS_Y = WS_P2 + 96 * MiB;
constexpr size_t WS_SSP = WS_R_END, WS_QE2 = WS_SSP + 1 * MiB, WS_OI = WS_QE2 + 32 * MiB, WS_END = WS_OI + 64 * MiB;
static_assert(WS_ACT + 88 * MiB <= WS_END && WS_Y + 32 * MiB <= WS_END, "ws map");

typedef __bf16 bf16x2_t __attribute__((ext_vector_type(2)));
__device__ __forceinline__ unsigned pk_bf16(float lo, float hi) { bf16x2_t v = {(__bf16)lo, (__bf16)hi}; return __builtin_bit_cast(unsigned, v); }
__device__ __forceinline__ float bf_lo(unsigned w) { return __uint_as_float(w << 16); }
__device__ __forceinline__ float bf_hi(unsigned w) { return __uint_as_float(w & 0xffff0000u); }
__device__ __forceinline__ float bf1(bf16 h) { return __uint_as_float(((unsigned)h) << 16); }
__device__ __forceinline__ float wave_sum(float v) {
#pragma unroll
    for (int o = 1; o < 64; o <<= 1) v += __shfl_xor(v, o);
    return v;
}
__device__ __forceinline__ int lane_id() { int l; asm volatile("v_mbcnt_lo_u32_b32 %0, -1, 0\n\tv_mbcnt_hi_u32_b32 %0, -1, %0" : "=v"(l)); return l; }
__device__ __forceinline__ float silu_f(float a) { return a * __builtin_amdgcn_rcpf(1.0f + __expf(-a)); }

__device__ __forceinline__ int hg_pos(int idx, int b0) { return 8 * (idx >> 2) + b0 + (idx & 3); }
struct CvtItem { const float* W; bf16* WT; const float* wk; int K, N, item; int perm; };
__device__ __forceinline__ void cvt_load(const CvtItem& d, int lane, f32x4 (&v)[8]) {
    const int nblk = d.N / 32, kb = d.item / nblk, nb = d.item % nblk, k0 = 64 * kb, n0 = 32 * nb;
#pragma unroll
    for (int i = 0; i < 8; ++i) { const int kk = i * 8 + (lane >> 3); v[i] = __builtin_nontemporal_load((const f32x4*)(d.W + (size_t)(k0 + kk) * d.N + n0 + 4 * (lane & 7))); }
}
__device__ __forceinline__ void cvt_store(const CvtItem& d, int lane, const f32x4 (&v)[8], LAS float* scr) {
    const int nblk = d.N / 32, kb = d.item / nblk, nb = d.item % nblk, k0 = 64 * kb, n0 = 32 * nb;
    const int r0 = d.perm == 1 ? (n0 < FF ? (n0 >> 7) * 256 + (n0 & 127) : ((n0 - FF) >> 7) * 256 + 128 + ((n0 - FF) & 127))
                 : d.perm == 2 ? (n0 < 2048 ? hg_pos(n0 >> 7, 0) * 256 + (n0 & 127) : (n0 < 4096 ? hg_pos((n0 - 2048) >> 7, 0) * 256 + 128 + ((n0 - 2048) & 127) : hg_pos((n0 >> 8) - 16, 4) * 256 + (n0 & 255))) : n0;
#pragma unroll
    for (int i = 0; i < 8; ++i) { const int kk = i * 8 + (lane >> 3); LAS float* dd = scr + kk * 33 + 4 * (lane & 7); dd[0] = v[i][0]; dd[1] = v[i][1]; dd[2] = v[i][2]; dd[3] = v[i][3]; }
    asm volatile("s_waitcnt lgkmcnt(0)" ::: "memory");
    const int c = lane & 7;
    f32x4 wa = {1.f, 1.f, 1.f, 1.f}, wb = {1.f, 1.f, 1.f, 1.f};
    if (d.wk) { wa = *(const f32x4*)(d.wk + k0 + 8 * c); wb = *(const f32x4*)(d.wk + k0 + 8 * c + 4); }
#pragma unroll
    for (int j = 0; j < 4; ++j) { const int n = (lane >> 3) + 8 * j; const LAS float* s = scr + (8 * c) * 33 + n;
        u32x4 o; o.x = pk_bf16(s[0 * 33] * wa[0], s[1 * 33] * wa[1]); o.y = pk_bf16(s[2 * 33] * wa[2], s[3 * 33] * wa[3]); o.z = pk_bf16(s[4 * 33] * wb[0], s[5 * 33] * wb[1]); o.w = pk_bf16(s[6 * 33] * wb[2], s[7 * 33] * wb[3]);
        *(u32x4*)(d.WT + (size_t)(r0 + n) * d.K + k0 + 8 * c) = o; }
    asm volatile("s_waitcnt lgkmcnt(0)" ::: "memory");
}
constexpr int I_IN = (D / 64) * (NIN / 32), I_OH = (D / 64) * (D / 32), I_UP = (D / 64) * (NUP / 32), I_DN = (FF / 64) * (D / 32), I_SI = (D / 64) * (NSC / 32), I_SO = I_OH;
constexpr int P0_ITEMS = I_IN + I_OH + I_UP + I_DN + I_SI + I_SO, T3_ITEMS = I_UP + I_DN;
struct CvtSrc { const float *hin, *hout, *up, *dn, *si, *so, *nffn, *nmix; unsigned char* ws; };
__device__ __forceinline__ CvtItem p0_item(const CvtSrc& s, int r) {
    if (r < I_IN) return CvtItem{s.hin, (bf16*)(s.ws + WS_WIN), nullptr, D, NIN, r, 2}; r -= I_IN;
    if (r < I_OH) return CvtItem{s.hout, (bf16*)(s.ws + WS_WOH), nullptr, D, D, r, 0}; r -= I_OH;
    if (r < I_UP) return CvtItem{s.up, (bf16*)(s.ws + WS_WUP0), s.nffn, D, NUP, r, 1}; r -= I_UP;
    if (r < I_DN) return CvtItem{s.dn, (bf16*)(s.ws + WS_WDN0), nullptr, FF, D, r, 0}; r -= I_DN;
    if (r < I_SI) return CvtItem{s.si, (bf16*)(s.ws + WS_WSI), s.nmix + D, D, NSC, r, 0}; r -= I_SI;
    return CvtItem{s.so, (bf16*)(s.ws + WS_WSO), nullptr, D, D, r, 0};
}
__device__ __forceinline__ CvtItem t3_item(const CvtSrc& s, int r) {
    if (r < I_UP) return CvtItem{s.up + (size_t)D * NUP, (bf16*)(s.ws + WS_WUP1), s.nffn + D, D, NUP, r, 1};
    return CvtItem{s.dn + (size_t)FF * D, (bf16*)(s.ws + WS_WDN1), nullptr, FF, D, r - I_UP, 0};
}
template <bool T3> __device__ __forceinline__ void cvt_run(const CvtSrc& s, int first, int stride, int nitems, LAS float* scr, int lane) {
    if (first >= nitems) return;
    f32x4 cur[8], nxt[8];
    CvtItem dc = T3 ? t3_item(s, first) : p0_item(s, first);
    cvt_load(dc, lane, cur);
    for (int it = first; it < nitems; it += stride) {
        const bool more = it + stride < nitems;
        CvtItem dn = dc;
        if (more) { dn = T3 ? t3_item(s, it + stride) : p0_item(s, it + stride); cvt_load(dn, lane, nxt); }
        cvt_store(dc, lane, cur, scr);
        if (more) {
#pragma unroll
            for (int i = 0; i < 8; ++i) cur[i] = nxt[i];
            dc = dn; }
    }
}

__device__ __forceinline__ void rms_row_bf16(const float* xrow, const float* w, bf16* orow, int lane) {
    const f32x4* xr = (const f32x4*)xrow + lane; const f32x4* wr = (const f32x4*)w + lane;
    f32x4 v[8]; float s = 0.f;
#pragma unroll
    for (int j = 0; j < 8; ++j) { v[j] = __builtin_nontemporal_load(xr + 64 * j); s += (v[j][0] * v[j][0] + v[j][1] * v[j][1]) + (v[j][2] * v[j][2] + v[j][3] * v[j][3]); }
    f32x4 gg[8];
#pragma unroll
    for (int j = 0; j < 8; ++j) gg[j] = wr[64 * j];
    const float rstd = __builtin_amdgcn_rsqf(wave_sum(s) * (1.0f / D) + EPS);
    u32x2* o8 = (u32x2*)orow + lane;
#pragma unroll
    for (int j = 0; j < 8; ++j) { const f32x4 g = gg[j]; u32x2 o; o.x = pk_bf16(v[j][0] * rstd * g[0], v[j][1] * rstd * g[1]); o.y = pk_bf16(v[j][2] * rstd * g[2], v[j][3] * rstd * g[3]); o8[64 * j] = o; }
}
__device__ __forceinline__ void rms_row_f32(const float* xrow, const float* w, float* orow, int lane) {
    const f32x4* xr = (const f32x4*)xrow + lane; const f32x4* wr = (const f32x4*)w + lane;
    f32x4 v[8]; float s = 0.f;
#pragma unroll
    for (int j = 0; j < 8; ++j) { v[j] = xr[64 * j]; s += (v[j][0] * v[j][0] + v[j][1] * v[j][1]) + (v[j][2] * v[j][2] + v[j][3] * v[j][3]); }
    const float rstd = __builtin_amdgcn_rsqf(wave_sum(s) * (1.0f / D) + EPS);
    f32x4* o = (f32x4*)orow + lane;
#pragma unroll
    for (int j = 0; j < 8; ++j) { const f32x4 g = wr[64 * j]; o[64 * j] = v[j] * rstd * g; }
}

__device__ __forceinline__ void unpack8(const u32x4 w, float (&f)[8]) { f[0] = bf_lo(w.x); f[1] = bf_hi(w.x); f[2] = bf_lo(w.y); f[3] = bf_hi(w.y); f[4] = bf_lo(w.z); f[5] = bf_hi(w.z); f[6] = bf_lo(w.w); f[7] = bf_hi(w.w); }
__device__ __forceinline__ void load8f(const float* p, float (&f)[8]) { const f32x4 a = *(const f32x4*)p, b = *(const f32x4*)(p + 4); f[0] = a[0]; f[1] = a[1]; f[2] = a[2]; f[3] = a[3]; f[4] = b[0]; f[5] = b[1]; f[6] = b[2]; f[7] = b[3]; }
template <int RS, int SEGSTRIDE> __device__ __forceinline__ void conv_glu_phase(const bf16* U, const float* cw  , bf16* ACT, int gtid, int gthreads) {
    constexpr int NCG = FF / 8, NSEG = M / SEGSTRIDE;
    for (int it = gtid; it < NCG * NSEG; it += gthreads) {
        const int jg = it % NCG, seg = it / NCG, c0 = jg * 8, t0 = seg * SEGSTRIDE;
        const bool first = (t0 & (SEQ - 1)) == 0;
        u32x4 rg[RS + 2], rv[RS + 2];
        const bf16* up = U + (size_t)(first ? t0 : t0 - 2) * NUP + c0;
#pragma unroll
        for (int r = 0; r < RS + 2; ++r) { const size_t o = (size_t)(first ? (r < 2 ? 0 : r - 2) : r) * NUP; rg[r] = *(const u32x4*)(up + o); rv[r] = *(const u32x4*)(up + o + FF); }
        float wg[3][8], wv[3][8];
#pragma unroll
        for (int k = 0; k < 3; ++k) { load8f(cw + k * NUP + c0, wg[k]); load8f(cw + k * NUP + FF + c0, wv[k]); }
        float g2[8], g1[8], v2[8], v1[8];
        unpack8(rg[0], g2); unpack8(rg[1], g1); unpack8(rv[0], v2); unpack8(rv[1], v1);
        if (first) {
#pragma unroll
            for (int j = 0; j < 8; ++j) { g2[j] = 0.f; g1[j] = 0.f; v2[j] = 0.f; v1[j] = 0.f; }
        }
#pragma unroll
        for (int r = 0; r < RS; ++r) {
            float g0[8], v0[8];
            unpack8(rg[r + 2], g0); unpack8(rv[r + 2], v0);
            float o[8];
#pragma unroll
            for (int j = 0; j < 8; ++j) { const float cgv = wg[0][j] * g2[j] + wg[1][j] * g1[j] + wg[2][j] * g0[j]; const float cvv = wv[0][j] * v2[j] + wv[1][j] * v1[j] + wv[2][j] * v0[j];
                o[j] = silu_f(cgv) * cvv; g2[j] = g1[j]; g1[j] = g0[j]; v2[j] = v1[j]; v1[j] = v0[j]; }
            u32x4 w; w.x = pk_bf16(o[0], o[1]); w.y = pk_bf16(o[2], o[3]); w.z = pk_bf16(o[4], o[5]); w.w = pk_bf16(o[6], o[7]);
            *(u32x4*)(ACT + (size_t)(t0 + r) * FF + c0) = w;
        }
    }
}
__device__ __forceinline__ void short_conv_phase(const bf16* P2, const float* cw  , bf16* Y, int gtid, int gthreads) {
    constexpr int NCG = D / 8, RS = 8, NSEG = M / RS;
    for (int it = gtid; it < NCG * NSEG; it += gthreads) {
        const int jg = it % NCG, seg = it / NCG, c0 = jg * 8, t0 = seg * RS;
        const bool first = (t0 & (SEQ - 1)) == 0;
        u32x4 rc[RS + 2], rh[RS + 2];
        const bf16* pp = P2 + (size_t)(first ? t0 : t0 - 2) * NSC + c0;
#pragma unroll
        for (int r = 0; r < RS + 2; ++r) { const size_t o = (size_t)(first ? (r < 2 ? 0 : r - 2) : r) * NSC; rc[r] = *(const u32x4*)(pp + o + D); rh[r] = *(const u32x4*)(pp + o + 2 * D); }
        u32x4 rb[RS];
#pragma unroll
        for (int r = 0; r < 4; ++r) rb[r] = *(const u32x4*)(P2 + (size_t)(t0 + r) * NSC + c0);
        float w3[3][8];
#pragma unroll
        for (int k = 0; k < 3; ++k) load8f(cw + k * D + c0, w3[k]);
        float z2[8], z1[8];
        { float a[8], b[8]; unpack8(rc[0], a); unpack8(rh[0], b);
#pragma unroll
          for (int j = 0; j < 8; ++j) z2[j] = first ? 0.f : a[j] * b[j];
          unpack8(rc[1], a); unpack8(rh[1], b);
#pragma unroll
          for (int j = 0; j < 8; ++j) z1[j] = first ? 0.f : a[j] * b[j]; }
#pragma unroll
        for (int r = 0; r < RS; ++r) {
            float gb[8], a[8], b[8], o[8];
            if (r == 2) {
#pragma unroll
                for (int q = 4; q < RS; ++q) rb[q] = *(const u32x4*)(P2 + (size_t)(t0 + q) * NSC + c0); }
            unpack8(rb[r], gb); unpack8(rc[r + 2], a); unpack8(rh[r + 2], b);
#pragma unroll
            for (int j = 0; j < 8; ++j) { const float z0 = a[j] * b[j]; o[j] = gb[j] * (w3[0][j] * z2[j] + w3[1][j] * z1[j] + w3[2][j] * z0); z2[j] = z1[j]; z1[j] = z0; }
            u32x4 w; w.x = pk_bf16(o[0], o[1]); w.y = pk_bf16(o[2], o[3]); w.z = pk_bf16(o[4], o[5]); w.w = pk_bf16(o[6], o[7]);
            *(u32x4*)(Y + (size_t)(t0 + r) * D + c0) = w;
        }
    }
}

__device__ __forceinline__ f32x4 mma_t(const bf16x8 a, const bf16x8 b, const f32x4 c) { return __builtin_amdgcn_mfma_f32_16x16x32_bf16(b, a, c, 0, 0, 0); }
constexpr int KT_LD = 72;
constexpr int R1_KET = 0, R1_VT = R1_KET + 128 * KT_LD * 2, R1_AM = R1_VT + 128 * KT_LD * 2, R1_END = R1_AM + 64 * KT_LD * 2;
static_assert(R1_END <= 131072, "R1 LDS");

__device__ __forceinline__ void r1_phase(unsigned char* lds, const bf16* QE, const bf16* KE, const bf16* V, bf16* OINTRA, bf16* UT, int nblk, int blk, const int wid, const int lane) {
    const int tid = wid * 64 + lane, fr = lane & 15, fq = lane >> 4;
    bf16* sKET = (bf16*)(lds + R1_KET); bf16* sVT = (bf16*)(lds + R1_VT); bf16* sAM = (bf16*)(lds + R1_AM);
    const int seg = tid >> 7, d = tid & 127;
    unsigned short kn[16], vn[16];
    if (blk < NTASK) { const int bh = blk >> 6, c = blk & 63, b_ = bh >> 4, h = bh & 15, m0 = b_ * SEQ + c * 64; const size_t gb = (size_t)(m0 + seg * 16) * D + h * HD + d;
#pragma unroll
        for (int i = 0; i < 16; ++i) { kn[i] = KE[gb + (size_t)i * D]; vn[i] = V[gb + (size_t)i * D]; } }
    for (int task = blk; task < NTASK; task += nblk) {
        const int bh = task >> 6, c = task & 63, b_ = bh >> 4, h = bh & 15, m0 = b_ * SEQ + c * 64;
        bf16x8 fa[2][4], fb[2][4];
#pragma unroll
        for (int q = 0; q < 2; ++q) { const int id = wid * 2 + q, ti = id >> 2, sj = id & 3;
            if (sj <= ti) {
#pragma unroll
                for (int kk = 0; kk < 4; ++kk) { fa[q][kk] = *(const bf16x8*)(QE + (size_t)(m0 + ti * 16 + fr) * D + h * HD + kk * 32 + fq * 8); fb[q][kk] = *(const bf16x8*)(KE + (size_t)(m0 + sj * 16 + fr) * D + h * HD + kk * 32 + fq * 8); } } }
        { u32x4 w0, w1;
          w0.x = kn[0] | ((unsigned)kn[1] << 16); w0.y = kn[2] | ((unsigned)kn[3] << 16); w0.z = kn[4] | ((unsigned)kn[5] << 16); w0.w = kn[6] | ((unsigned)kn[7] << 16);
          w1.x = kn[8] | ((unsigned)kn[9] << 16); w1.y = kn[10] | ((unsigned)kn[11] << 16); w1.z = kn[12] | ((unsigned)kn[13] << 16); w1.w = kn[14] | ((unsigned)kn[15] << 16);
          *(u32x4*)(sKET + d * KT_LD + seg * 16) = w0; *(u32x4*)(sKET + d * KT_LD + seg * 16 + 8) = w1;
          w0.x = vn[0] | ((unsigned)vn[1] << 16); w0.y = vn[2] | ((unsigned)vn[3] << 16); w0.z = vn[4] | ((unsigned)vn[5] << 16); w0.w = vn[6] | ((unsigned)vn[7] << 16);
          w1.x = vn[8] | ((unsigned)vn[9] << 16); w1.y = vn[10] | ((unsigned)vn[11] << 16); w1.z = vn[12] | ((unsigned)vn[13] << 16); w1.w = vn[14] | ((unsigned)vn[15] << 16);
          *(u32x4*)(sVT + d * KT_LD + seg * 16) = w0; *(u32x4*)(sVT + d * KT_LD + seg * 16 + 8) = w1; }
        if (task + nblk < NTASK) { const int tn = task + nblk, bhn = tn >> 6, cn = tn & 63, bn = bhn >> 4, hn = bhn & 15, m0n = bn * SEQ + cn * 64; const size_t gb = (size_t)(m0n + seg * 16) * D + hn * HD + d;
#pragma unroll
            for (int i = 0; i < 16; ++i) { kn[i] = KE[gb + (size_t)i * D]; vn[i] = V[gb + (size_t)i * D]; } }
#pragma unroll
        for (int q = 0; q < 2; ++q) { const int id = wid * 2 + q, ti = id >> 2, sj = id & 3; f32x4 acc = {0.f, 0.f, 0.f, 0.f};
            if (sj <= ti) {
#pragma unroll
                for (int kk = 0; kk < 4; ++kk) acc = mma_t(fa[q][kk], fb[q][kk], acc);
                const int t = ti * 16 + fr, s0 = sj * 16 + 4 * fq;
#pragma unroll
                for (int j = 0; j < 4; ++j) if (s0 + j > t) acc[j] = 0.f;
            }
            u32x2 w; w.x = pk_bf16(acc[0], acc[1]); w.y = pk_bf16(acc[2], acc[3]);
            *(u32x2*)(sAM + (ti * 16 + fr) * KT_LD + sj * 16 + 4 * fq) = w; }
        __syncthreads();
        { const bf16x8 a0 = *(const bf16x8*)(sVT + (wid * 16 + fr) * KT_LD + fq * 8), a1 = *(const bf16x8*)(sVT + (wid * 16 + fr) * KT_LD + 32 + fq * 8);
          bf16* up = UT + (size_t)task * 16384 + (size_t)(wid * 16 + fr) * 128 + 4 * fq;
#pragma unroll
          for (int dj = 0; dj < 8; ++dj) { const bf16x8 b0 = *(const bf16x8*)(sKET + (dj * 16 + fr) * KT_LD + fq * 8), b1 = *(const bf16x8*)(sKET + (dj * 16 + fr) * KT_LD + 32 + fq * 8);
              f32x4 acc = {0.f, 0.f, 0.f, 0.f}; acc = mma_t(a0, b0, acc); acc = mma_t(a1, b1, acc); u32x2 w; w.x = pk_bf16(acc[0], acc[1]); w.y = pk_bf16(acc[2], acc[3]); *(u32x2*)(up + dj * 16) = w; } }
        { const int ti = wid >> 1; const bf16x8 a0 = *(const bf16x8*)(sAM + (ti * 16 + fr) * KT_LD + fq * 8), a1 = *(const bf16x8*)(sAM + (ti * 16 + fr) * KT_LD + 32 + fq * 8);
          bf16* op = OINTRA + (size_t)(m0 + ti * 16 + fr) * D + h * HD + 4 * fq;
#pragma unroll
          for (int q = 0; q < 4; ++q) { const int vj = (wid & 1) * 4 + q; const bf16x8 b0 = *(const bf16x8*)(sVT + (vj * 16 + fr) * KT_LD + fq * 8), b1 = *(const bf16x8*)(sVT + (vj * 16 + fr) * KT_LD + 32 + fq * 8);
              f32x4 acc = {0.f, 0.f, 0.f, 0.f}; acc = mma_t(a0, b0, acc); acc = mma_t(a1, b1, acc); u32x2 w; w.x = pk_bf16(acc[0], acc[1]); w.y = pk_bf16(acc[2], acc[3]); *(u32x2*)(op + vj * 16) = w; } }
        __syncthreads();
    }
}
struct R2Set { u32x2 uw[4]; f32x4 er[4], ebr[4], dc[4]; };
__device__ __forceinline__ void r2_load(R2Set& s, const bf16* UT, const float* VEC, size_t task0, int rem, int d4) {
#pragma unroll
    for (int i = 0; i < 4; ++i) { const size_t task = task0 + i;
        s.uw[i] = *(const u32x2*)(UT + task * 16384 + (size_t)rem * 4);
        s.er[i] = *(const f32x4*)(VEC + task * 128 + d4); s.ebr[i] = *(const f32x4*)(VEC + 2048 * 128 + task * 128 + d4); s.dc[i] = *(const f32x4*)(VEC + 2 * 2048 * 128 + task * 128 + d4); }
}
__device__ __forceinline__ void r2_phase(const bf16* UT, const float* VEC, bf16* SP, int gtid, int gthreads) {
    for (int e = gtid; e < 32 * 4096; e += gthreads) {
        const int bh = e >> 12, rem = e & 4095, d4 = (rem & 31) * 4;
        f32x4 S = {0.f, 0.f, 0.f, 0.f};
        R2Set cur, nxt;
        r2_load(cur, UT, VEC, (size_t)bh * 64, rem, d4);
        for (int c0 = 0; c0 < 64; c0 += 4) {
            if (c0 + 4 < 64) r2_load(nxt, UT, VEC, (size_t)bh * 64 + c0 + 4, rem, d4);
#pragma unroll
            for (int i = 0; i < 4; ++i) { const size_t task = (size_t)bh * 64 + c0 + i;
                const f32x4 Sp = S * cur.er[i];
                u32x2 w; w.x = pk_bf16(Sp[0], Sp[1]); w.y = pk_bf16(Sp[2], Sp[3]); *(u32x2*)(SP + task * 16384 + (size_t)rem * 4) = w;
                const f32x4 u = {bf_lo(cur.uw[i].x), bf_hi(cur.uw[i].x), bf_lo(cur.uw[i].y), bf_hi(cur.uw[i].y)};
                S = cur.dc[i] * S + cur.ebr[i] * u; }
            if (c0 + 4 < 64) cur = nxt;
        }
    }
}
struct R3Set { bf16x8 a[4]; bf16x8 b[4][4]; u32x2 oi[4]; u32x2 g[4]; };
__device__ __forceinline__ void r3_load(R3Set& s, int un, const bf16* QE2, const bf16* SP, const bf16* OINTRA, const bf16* G, int fr, int fq) {
    const int task = un >> 3, ti = (un >> 1) & 3, half = un & 1, bh = task >> 6, c = task & 63, b_ = bh >> 4, h = bh & 15, row = b_ * SEQ + c * 64 + ti * 16 + fr;
    const bf16* ap = QE2 + (size_t)row * D + h * HD + fq * 8;
#pragma unroll
    for (int kk = 0; kk < 4; ++kk) s.a[kk] = *(const bf16x8*)(ap + kk * 32);
    const bf16* sp = SP + (size_t)task * 16384 + (size_t)(half * 64 + fr) * 128 + fq * 8; const size_t obase = (size_t)row * D + h * HD + half * 64 + 4 * fq;
#pragma unroll
    for (int q = 0; q < 4; ++q) { s.oi[q] = *(const u32x2*)(OINTRA + obase + q * 16); s.g[q] = *(const u32x2*)(G + obase + q * 16);
#pragma unroll
        for (int kk = 0; kk < 4; ++kk) s.b[q][kk] = *(const bf16x8*)(sp + (size_t)q * 16 * 128 + kk * 32); }
}
__device__ __forceinline__ void r3_phase(const bf16* QE2, const bf16* SP, const bf16* OINTRA, const bf16* G, const float* gain, bf16* OG, float* SSO, int gw, int ngw, int lane) {
    const int fr = lane & 15, fq = lane >> 4;
    R3Set cur, nxt;
    if (gw < NTASK * 8) r3_load(cur, gw, QE2, SP, OINTRA, G, fr, fq);
    for (int un = gw; un < NTASK * 8; un += ngw) {
        const bool more = un + ngw < NTASK * 8;
        if (more) r3_load(nxt, un + ngw, QE2, SP, OINTRA, G, fr, fq);
        const int task = un >> 3, ti = (un >> 1) & 3, half = un & 1, bh = task >> 6, c = task & 63, b_ = bh >> 4, h = bh & 15, row = b_ * SEQ + c * 64 + ti * 16 + fr;
        const size_t obase = (size_t)row * D + h * HD + half * 64 + 4 * fq;
        float ssum = 0.f;
#pragma unroll
        for (int q = 0; q < 4; ++q) { f32x4 acc = {bf_lo(cur.oi[q].x), bf_hi(cur.oi[q].x), bf_lo(cur.oi[q].y), bf_hi(cur.oi[q].y)};
            const f32x4 gn = *(const f32x4*)(gain + h * HD + half * 64 + q * 16 + 4 * fq);
#pragma unroll
            for (int kk = 0; kk < 4; ++kk) acc = mma_t(cur.a[kk], cur.b[q][kk], acc);
            ssum += (acc[0] * acc[0] + acc[1] * acc[1]) + (acc[2] * acc[2] + acc[3] * acc[3]);
            u32x2 w; w.x = pk_bf16(acc[0] * gn[0] * bf_lo(cur.g[q].x), acc[1] * gn[1] * bf_hi(cur.g[q].x)); w.y = pk_bf16(acc[2] * gn[2] * bf_lo(cur.g[q].y), acc[3] * gn[3] * bf_hi(cur.g[q].y));
            *(u32x2*)(OG + obase + q * 16) = w; }
        ssum += __shfl_xor(ssum, 16); ssum += __shfl_xor(ssum, 32);
        if (fq == 0) unsafeAtomicAdd(SSO + row, ssum);
        if (more) cur = nxt;
    }
}

#define XB_TMO      128
#define XB_XCNT(j)  (256  + 64 * (j))
#define XB_XSUB(j)  (1280 + 64 * (j))
#define XB_XGEN(j)  (2304 + 64 * (j))
#define XB_TOP      3328
#define XB_TOPGEN   3392
#define XCD_BAR_WORDS 3456
#define XB_SPIN_CAP (1u << 20)
__device__ __forceinline__ unsigned xb_ld(unsigned* p)              { return __hip_atomic_load(p, __ATOMIC_RELAXED, __HIP_MEMORY_SCOPE_AGENT); }
__device__ __forceinline__ unsigned xb_add(unsigned* p, unsigned v) { return __hip_atomic_fetch_add(p, v, __ATOMIC_RELAXED, __HIP_MEMORY_SCOPE_AGENT); }
__device__ __forceinline__ unsigned xb_xcc_id() { return (unsigned)__builtin_amdgcn_s_getreg((3 << 11) | 20) & 0xFu; }
#define XB_SPIN(cond, bar) do { unsigned _sp = 0; while (cond) { __builtin_amdgcn_s_sleep(1); \
    if ((++_sp & 255u) == 0u) { if (xb_ld(&(bar)[XB_TMO])) break; if (_sp > XB_SPIN_CAP) { atomicAdd(&(bar)[XB_TMO], 1u); break; } } } } while (0)
__device__ __forceinline__ void xcd_barrier_complete(unsigned* bar, unsigned x, unsigned G, unsigned& nloc, unsigned& nx) {
    unsigned sum, cnt, mine, sp = 0u;
    for (;;) {
        sum = 0u; cnt = 0u; mine = 0u;
#pragma unroll
        for (unsigned j = 0; j < 16; ++j) { const unsigned c = xb_ld(&bar[XB_XCNT(j)]); sum += c; cnt += (c > 0u) ? 1u : 0u; mine = (j == x) ? c : mine; }
        if (sum == G) break;
        __builtin_amdgcn_s_sleep(1);
        if ((++sp & 255u) == 0u) { if (xb_ld(&bar[XB_TMO])) break; if (sp > XB_SPIN_CAP) { atomicAdd(&bar[XB_TMO], 1u); break; } }
    }
    nloc = mine > 0u ? mine : 1u; nx = cnt > 0u ? cnt : 1u;
}
__device__ __forceinline__ void xcd_barrier(unsigned* bar, volatile LAS unsigned* st, int wave, unsigned G) {
    asm volatile("s_waitcnt vmcnt(0)" ::: "memory");
    __syncthreads();
    if (wave == 0 && lane_id() == 0) {
        const unsigned x = xb_xcc_id();
        __builtin_amdgcn_s_waitcnt(0);
        unsigned nloc = st[0], nx = st[1];
        if (nloc == 0u) { xcd_barrier_complete(bar, x, G, nloc, nx); st[0] = nloc; st[1] = nx; }
        const unsigned old = xb_add(&bar[XB_XSUB(x)], 1u);
        const unsigned gen = old / nloc;
        if (old + 1u == (gen + 1u) * nloc) {
            __builtin_amdgcn_fence(__ATOMIC_RELEASE, "agent");
            asm volatile("s_waitcnt vmcnt(0)" ::: "memory");
            const unsigned og = xb_add(&bar[XB_TOP], 1u);
            const unsigned tg = og / nx;
            if (og + 1u == (tg + 1u) * nx) xb_add(&bar[XB_TOPGEN], 1u);
            else XB_SPIN(xb_ld(&bar[XB_TOPGEN]) == tg, bar);
            __builtin_amdgcn_fence(__ATOMIC_ACQUIRE, "agent");
            xb_add(&bar[XB_XGEN(x)], 1u);
            asm volatile("s_waitcnt vmcnt(0)" ::: "memory");
        } else {
            XB_SPIN(xb_ld(&bar[XB_XGEN(x)]) == gen, bar);
            __builtin_amdgcn_fence(__ATOMIC_ACQUIRE, "agent");
            asm volatile("s_waitcnt vmcnt(0)" ::: "memory");
        }
    }
    __syncthreads();
}

enum { PH_P0 = 0, PH_G1, PH_R1, PH_R2, PH_R3, PH_G2, PH_N1, PH_G3, PH_C1, PH_G4, PH_N2, PH_G5, PH_C2, PH_G6, PH_N3, PH_G7, PH_C3, PH_G8, PH_FN, NPH };
struct Args { const float* in[14]; float* out; unsigned char* ws; int ph_lo, ph_hi; };

__global__ void __launch_bounds__(NTHR, 2) trunk_fwd(Args args) {
    extern __shared__ __attribute__((aligned(16))) unsigned char lds[];
    const int wave = __builtin_amdgcn_readfirstlane(threadIdx.x >> 6);
    const int G_ = gridDim.x, blk = blockIdx.x, ngw = G_ * NWAVES, gthreads = G_ * NTHR;
#define LANE_SETUP() int lane = lane_id(); asm volatile("" : "+v"(lane)); const int tid = wave * 64 + lane, gw = blk * NWAVES + wave, gtid = blk * NTHR + tid; (void)tid; (void)gw; (void)gtid
    unsigned char* ws = args.ws;
    float* H = args.out;
    bf16* XN = (bf16*)(ws + WS_XN);
    const int lo = args.ph_lo, hi = args.ph_hi;
#define IN(k) (lo <= (k) && (k) < hi)
    if (lo < 0) cg::this_grid().sync();
    volatile LAS unsigned* bst = (volatile LAS unsigned*)((LAS unsigned char*)lds + 131072 + 1024);
    unsigned* bar = (unsigned*)ws;
    {
        if (wave == 0) { const int l0 = lane_id(); if (l0 < 2) bst[l0] = 0u; if (l0 == 0) (void)xb_add(&bar[XB_XCNT(xb_xcc_id())], 1u); }
        __syncthreads();
    }
#define SEAM(k) do { xcd_barrier(bar, bst, wave, (unsigned)G_); } while (0)
#define RUN_GEMM(MODE, KC, Aptr, Bptr, NN, SETUP) do { pg8::Gemm g{(const bf16*)(Aptr), (const bf16*)(Bptr), M, (NN), (KC)}; pg8::Epi<MODE, KC> E{}; SETUP; \
        pg8::StaticOrder S; S.init(M, (NN), G_, blk); pg8::gemm_phase<pg8::Epi<MODE, KC>, pg8::StaticOrder, true, true>((LAS unsigned char*)lds, g, S, E, wave); } while (0)
    { LANE_SETUP();
        LAS float* scr = (LAS float*)((LAS unsigned char*)lds + wave * 16384);
        { const CvtSrc cs{args.in[3], args.in[6], args.in[10], args.in[12], args.in[7], args.in[9], args.in[2], args.in[1], ws};
          cvt_run<false>(cs, gw, ngw, P0_ITEMS, scr, lane); }
        for (int m = gw; m < M; m += ngw) rms_row_bf16(args.in[0] + (size_t)m * D, args.in[1], XN + (size_t)m * D, lane);
        for (int i = gtid; i < 5 * M; i += gthreads) ((float*)(ws + WS_SSP))[i] = 0.f;
        SEAM(PH_P0);
    }
#pragma nounroll
    for (int L = 0; L < 2; ++L) {
        if (L == 0) {
            RUN_GEMM(4, 2048, XN, ws + WS_WIN, NIN, (E.Q = (bf16*)(ws + WS_Q), E.KE = (bf16*)(ws + WS_LOGF), E.LOGF = (float*)(ws + WS_LOGF + 32 * MiB), E.V = (bf16*)(ws + WS_V), E.G = (bf16*)(ws + WS_G), E.lbt = args.in[4]));
            SEAM(PH_G1);
            { LANE_SETUP();
              r1_phase(lds, (const bf16*)(ws + WS_Q), (const bf16*)(ws + WS_LOGF), (const bf16*)(ws + WS_V), (bf16*)(ws + WS_OI), (bf16*)(ws + WS_UT), G_, blk, wave, lane); }
            SEAM(PH_R1);
            { LANE_SETUP();
              r2_phase((const bf16*)(ws + WS_UT), (const float*)(ws + WS_LOGF + 32 * MiB), (bf16*)(ws + WS_SP), gtid, gthreads); }
            SEAM(PH_R2);
            { LANE_SETUP();
              r3_phase((const bf16*)(ws + WS_Q), (const bf16*)(ws + WS_SP), (const bf16*)(ws + WS_OI), (const bf16*)(ws + WS_G), args.in[5], (bf16*)(ws + WS_V), (float*)(ws + WS_SSP) + 3 * M, gw, ngw, lane); }
            SEAM(PH_R3);
        } else {
            RUN_GEMM(0, 2048, XN, ws + WS_WSI, NSC, (E.O = (bf16*)(ws + WS_P2), E.ldc = NSC, E.ssp_in = (const float*)(ws + WS_SSP) + 1 * M));
            SEAM(PH_G5);
            { LANE_SETUP();
              short_conv_phase((const bf16*)(ws + WS_P2), args.in[8], (bf16*)(ws + WS_Y), gtid, gthreads); }
            SEAM(PH_C2);
        }
        RUN_GEMM(1, 2048, ws + (L ? WS_Y : WS_V), ws + (L ? WS_WSO : WS_WOH), D, (E.out = nullptr, E.res = args.in[0], E.resb = L ? (const bf16*)XN : (const bf16*)nullptr, E.ss = L ? (const float*)nullptr : (const float*)(ws + WS_SSP) + 3 * M, E.hb = XN, E.ssp_out = (float*)(ws + WS_SSP) + (L ? 2 * M : 0)));
        SEAM(PH_G2);
        RUN_GEMM(3, 2048, XN, ws + (L ? WS_WUP1 : WS_WUP0), NUP, (E.O = (bf16*)(ws + WS_ACT), E.Ub = (bf16*)(ws + WS_U), E.cw = args.in[11] + (L ? 3 * NUP : 0), E.ssp_in = (const float*)(ws + WS_SSP) + (L ? 2 * M : 0)));
        if (L == 0) {
            const int nrem = ((NUP / 256) * (M / 256)) % G_, first_idle = nrem, nconv = G_ - first_idle;
            if (blk >= first_idle) { LANE_SETUP();
                LAS float* scr = (LAS float*)((LAS unsigned char*)lds + wave * 16384);
                const CvtSrc cs{args.in[3], args.in[6], args.in[10], args.in[12], args.in[7], args.in[9], args.in[2], args.in[1], ws};
                cvt_run<true>(cs, (blk - first_idle) * NWAVES + wave, nconv * NWAVES, T3_ITEMS, scr, lane); }
        }
        SEAM(PH_G3);
        { LANE_SETUP();
          conv_glu_phase<2, 64>((const bf16*)(ws + WS_U), args.in[11] + (L ? 3 * NUP : 0), (bf16*)(ws + WS_ACT), gtid, gthreads); }
        SEAM(PH_C1);
        RUN_GEMM(1, 5632, ws + WS_ACT, ws + (L ? WS_WDN1 : WS_WDN0), D, (E.out = nullptr, E.res = nullptr, E.resb = XN, E.ss = nullptr, E.hb = XN, E.ssp_out = (float*)(ws + WS_SSP) + (L ? 4 * M : 1 * M)));
        SEAM(PH_G4);
    }
    { LANE_SETUP();
        const float* ssq = (const float*)(ws + WS_SSP) + 4 * M; const f32x4* wr = (const f32x4*)args.in[13];
        for (int it = gtid; it < M * (D / 8); it += gthreads) { const int row = it >> 8, c8 = (it & 255) * 8;
            const u32x4 hw = __builtin_nontemporal_load((const u32x4*)(XN + (size_t)row * D + c8)); const float rstd = __builtin_amdgcn_rsqf(ssq[row] * (1.0f / D) + EPS);
            const f32x4 g0 = wr[c8 >> 2], g1 = wr[(c8 >> 2) + 1];
            f32x4 o0 = {bf_lo(hw.x), bf_hi(hw.x), bf_lo(hw.y), bf_hi(hw.y)}, o1 = {bf_lo(hw.z), bf_hi(hw.z), bf_lo(hw.w), bf_hi(hw.w)};
            o0 = o0 * rstd * g0; o1 = o1 * rstd * g1;
            f32x4* op = (f32x4*)(H + (size_t)row * D + c8); __builtin_nontemporal_store(o0, op); __builtin_nontemporal_store(o1, op + 1); }
    }
#undef IN
#undef LANE_SETUP
#undef SEAM
#undef RUN_GEMM
}

extern "C" void kernel_launch(void* const* d_in, const int* in_sizes, int n_in, void* d_out, int out_size, void* d_ws, size_t ws_size, hipStream_t stream) {
    static int grid = 0;
    if (grid == 0) {
        if (n_in != 14 || in_sizes[0] != M * D || out_size != M * D || ws_size < WS_END) { fprintf(stderr, "kernel_launch: unexpected shapes (n_in %d, in0 %d, out %d, ws %zu < %zu)\n", n_in, n_in > 0 ? in_sizes[0] : -1, out_size, ws_size, (size_t)WS_END); grid = -1; return; }
        int dev = 0, cus = 0, per_cu = 0;
        if (hipGetDevice(&dev) != hipSuccess || hipDeviceGetAttribute(&cus, hipDeviceAttributeMultiprocessorCount, dev) != hipSuccess) { grid = -1; return; }
        if (hipFuncSetAttribute((const void*)trunk_fwd, hipFuncAttributeMaxDynamicSharedMemorySize, LDS_BYTES) != hipSuccess) { fprintf(stderr, "kernel_launch: hipFuncSetAttribute failed\n"); grid = -1; return; }
        if (hipOccupancyMaxActiveBlocksPerMultiprocessor(&per_cu, (const void*)trunk_fwd, NTHR, LDS_BYTES) != hipSuccess || per_cu < 1) { fprintf(stderr, "kernel_launch: occupancy query says %d\n", per_cu); per_cu = 1; }
        (void)hipGetLastError();
        grid = cus * 1;
    }
    if (grid < 0) return;
    if (hipMemsetAsync(d_ws, 0, 16384, stream) != hipSuccess) { fprintf(stderr, "kernel_launch: memset failed\n"); return; }
    Args a{};
    for (int i = 0; i < 14; ++i) a.in[i] = (const float*)d_in[i];
    a.out = (float*)d_out; a.ws = (unsigned char*)d_ws;
#if MK_SINGLE
    a.ph_lo = 0; a.ph_hi = NPH;
    void* kargs[] = {&a};
    hipError_t e = hipLaunchCooperativeKernel((const void*)trunk_fwd, dim3(grid), dim3(NTHR), kargs, LDS_BYTES, stream);
    if (e != hipSuccess) fprintf(stderr, "kernel_launch: cooperative launch failed: %s (grid %d)\n", hipGetErrorString(e), grid);
#else
    for (int p = 0; p < NPH; ++p) { a.ph_lo = p; a.ph_hi = p + 1; hipLaunchKernelGGL(trunk_fwd, dim3(grid), dim3(NTHR), LDS_BYTES, stream, a); }
#endif
}
```

```cpp
#include <hip/hip_runtime.h>
#include <hip/hip_cooperative_groups.h>
#include <cstdio>
#include <cstdint>
namespace cg = cooperative_groups;
#ifndef MK_SINGLE
#define MK_SINGLE 1
#endif
namespace pg8 {
#define PG8_LAS __attribute__((address_space(3)))
typedef unsigned short bf16_t;
typedef short bf16x8 __attribute__((ext_vector_type(8)));
typedef float f32x4 __attribute__((ext_vector_type(4)));
typedef unsigned u32x4 __attribute__((ext_vector_type(4)));
constexpr int BM = 256, BK = 64, HALF = 128, HTB = HALF * BK * 2  , STAGE_BYTES = 8 * HTB, NXCD = 8, WGM = 8;

__host__ __device__ __forceinline__ int lds_byte(int r, int c) { const int st = (r >> 4) * 2 + (c >> 5), rr = r & 15, cc = c & 31, ob = rr * 64 + cc * 2; return st * 1024 + (ob ^ (((ob >> 9) & 1) << 5)); }
__host__ __device__ __forceinline__ void stage_rc(int b, int& R, int& C) { const int st = b / 1024, sb = b % 1024, swz = sb ^ (((sb >> 9) & 1) << 5); R = (st >> 1) * 16 + swz / 64; C = (st & 1) * 32 + (swz % 64) / 2; }
__host__ __device__ __forceinline__ int perm32(int rho) { const int n = rho >> 4, i = rho & 15; return 8 * (i >> 2) + 4 * n + (i & 3); }

struct Unit { int pm, pn; };
struct Gemm { const bf16_t* A; const bf16_t* Bt; int M, N, K; };

struct StaticOrder {
    int nM, nN, nwg, G, c;
    __host__ __device__ void init(int M, int N, int G_, int c_) { nM = M / BM; nN = N / BM; nwg = nM * nN; G = G_; c = c_; }
    __host__ __device__ bool next(int i, Unit& u) const {
        const long L = (long)i * G + c; if (L >= nwg) return false;
        int wgid = (int)L; { const int q = nwg / NXCD, r = nwg % NXCD, xcd = wgid % NXCD, off = wgid / NXCD; wgid = (xcd < r ? xcd * (q + 1) : r * (q + 1) + (xcd - r) * q) + off; }
        const int nig = WGM * nN, gid = wgid / nig, fm = gid * WGM, gsz = (nM - fm) < WGM ? (nM - fm) : WGM;
        u.pm = fm + ((wgid % nig) % gsz); u.pn = (wgid % nig) / gsz; return true;
    }
    __device__ __forceinline__ void a_ready(const Unit&) const {}
    __device__ __forceinline__ void done(const Unit&) const {}
};
__device__ __forceinline__ unsigned cvt_pk_bf16(float lo, float hi) { unsigned r; asm volatile("v_cvt_pk_bf16_f32 %0, %1, %2" : "=v"(r) : "v"(lo), "v"(hi)); return r; }
typedef float f32x2 __attribute__((ext_vector_type(2)));
typedef unsigned u32x2 __attribute__((ext_vector_type(2)));
__device__ __forceinline__ float ror1(float v) { return __int_as_float(__builtin_amdgcn_update_dpp(0, __float_as_int(v), 0x121, 0xf, 0xf, true)); }
__device__ __forceinline__ float ror2(float v) { return __int_as_float(__builtin_amdgcn_update_dpp(0, __float_as_int(v), 0x122, 0xf, 0xf, true)); }
template <int K_> __device__ __forceinline__ float shr_dpp(float v) { return __int_as_float(__builtin_amdgcn_update_dpp(0, __float_as_int(v), 0x110 + K_, 0xf, 0xf, true)); }
__device__ __forceinline__ float bc15_dpp(float v) { return __int_as_float(__builtin_amdgcn_update_dpp(0, __float_as_int(v), 0x15F, 0xf, 0xf, false)); }
template <int K_> __device__ __forceinline__ float shr_keep(float old, float v) { return __int_as_float(__builtin_amdgcn_update_dpp(__float_as_int(old), __float_as_int(v), 0x110 + K_, 0xf, 0xf, false)); }
template <int mode, int KC_> struct Epi {
    static constexpr bool PERM = true, AFTER_DRAIN = false; static constexpr int KC = KC_;
    bf16_t* O; int ldc; const float* ssp_in;
    bf16_t* Ub; const float* cw;
    bf16_t* hb; float* ssp_out;
    const bf16_t* resb;
    float* out; const float* res; const float* ss;
    bf16_t* Q; float* LOGF; bf16_t* V; bf16_t* G; const float* lbt;
    bf16_t* KE;
    __device__ __forceinline__ void operator()(const f32x4 (&acc)[2][2][4][2], const Unit& u, int wr, int wc, int fr_, int fq_) const {
        int l_; asm volatile("v_mbcnt_lo_u32_b32 %0, -1, 0\n\tv_mbcnt_hi_u32_b32 %0, -1, %0" : "=v"(l_));
        const int fr = l_ & 15, fq = l_ >> 4; (void)fr_; (void)fq_;
        const int row0 = u.pm * BM + wr * 64 + fr;
        if constexpr (mode == 0) {
            const int col0 = u.pn * BM + wc * 32 + 8 * fq;
            float rs[2][4];
#pragma unroll
            for (int ai = 0; ai < 2; ++ai)
#pragma unroll
                for (int m = 0; m < 4; ++m) rs[ai][m] = ssp_in ? ssp_in[row0 + ai * HALF + m * 16] : 1.0f;
            if (ssp_in) {
#pragma unroll
                for (int ai = 0; ai < 2; ++ai)
#pragma unroll
                    for (int m = 0; m < 4; ++m) rs[ai][m] = __builtin_amdgcn_rsqf(rs[ai][m] * (1.0f / 2048.0f) + 1e-6f); }
#pragma unroll
            for (int ai = 0; ai < 2; ++ai)
#pragma unroll
                for (int m = 0; m < 4; ++m) { const int row = row0 + ai * HALF + m * 16; bf16_t* rowp = O + (size_t)row * ldc + col0;
#pragma unroll
                    for (int bj = 0; bj < 2; ++bj) { const f32x4 v0 = acc[ai][bj][m][0] * rs[ai][m], v1 = acc[ai][bj][m][1] * rs[ai][m];
                        u32x4 w; w.x = cvt_pk_bf16(v0[0], v0[1]); w.y = cvt_pk_bf16(v0[2], v0[3]); w.z = cvt_pk_bf16(v1[0], v1[1]); w.w = cvt_pk_bf16(v1[2], v1[3]);
                        *(u32x4*)(rowp + bj * HALF) = w; } }
        } else if constexpr (mode == 1) {
            const int col0 = u.pn * BM + wc * 32 + 8 * fq;
            float sc8[2][4];
#pragma unroll
            for (int ai = 0; ai < 2; ++ai)
#pragma unroll
                for (int m = 0; m < 4; ++m) sc8[ai][m] = ss ? ss[row0 + ai * HALF + m * 16] : 1.0f;
            if (ss) {
#pragma unroll
                for (int ai = 0; ai < 2; ++ai)
#pragma unroll
                    for (int m = 0; m < 4; ++m) sc8[ai][m] = __builtin_amdgcn_rsqf(sc8[ai][m] * (1.0f / 2048.0f) + 1e-6f); }
#pragma unroll
            for (int ai = 0; ai < 2; ++ai) {
            u32x4 RW[4][2];
            if (resb) {
#pragma unroll
                for (int m = 0; m < 4; ++m)
#pragma unroll
                    for (int bj = 0; bj < 2; ++bj) RW[m][bj] = *(const u32x4*)(resb + (size_t)(row0 + ai * HALF + m * 16) * 2048 + col0 + bj * HALF); }
#pragma unroll
                for (int m = 0; m < 4; ++m) { const int row = row0 + ai * HALF + m * 16; const size_t off = (size_t)row * 2048 + col0;
                    const float sc = sc8[ai][m];
                    float ssq = 0.f;
#pragma unroll
                    for (int bj = 0; bj < 2; ++bj) { f32x4 r0, r1;
                        if (resb) { const u32x4 rw = RW[m][bj];
                            r0 = (f32x4){__uint_as_float(rw.x << 16), __uint_as_float(rw.x & 0xffff0000u), __uint_as_float(rw.y << 16), __uint_as_float(rw.y & 0xffff0000u)};
                            r1 = (f32x4){__uint_as_float(rw.z << 16), __uint_as_float(rw.z & 0xffff0000u), __uint_as_float(rw.w << 16), __uint_as_float(rw.w & 0xffff0000u)}; }
                        else { r0 = *(const f32x4*)(res + off + bj * HALF); r1 = *(const f32x4*)(res + off + bj * HALF + 4); }
                        const f32x4 o0 = r0 + acc[ai][bj][m][0] * sc, o1 = r1 + acc[ai][bj][m][1] * sc;
                        if (out) { *(f32x4*)(out + off + bj * HALF) = o0; *(f32x4*)(out + off + bj * HALF + 4) = o1; }
                        ssq += ((o0[0] * o0[0] + o0[1] * o0[1]) + (o0[2] * o0[2] + o0[3] * o0[3])) + ((o1[0] * o1[0] + o1[1] * o1[1]) + (o1[2] * o1[2] + o1[3] * o1[3]));
                        if (hb) { u32x4 w; w.x = cvt_pk_bf16(o0[0], o0[1]); w.y = cvt_pk_bf16(o0[2], o0[3]); w.z = cvt_pk_bf16(o1[0], o1[1]); w.w = cvt_pk_bf16(o1[2], o1[3]); *(u32x4*)(hb + off + bj * HALF) = w; } }
                    if (ssp_out) { ssq += __shfl_xor(ssq, 16); ssq += __shfl_xor(ssq, 32); if (fq == 0) unsafeAtomicAdd(ssp_out + row, ssq); }
                    if (!resb) asm volatile("" ::: "memory"); }
            asm volatile("" ::: "memory"); }
        } else if constexpr (mode == 3) {
            const int cbase = u.pn * 128 + wc * 32 + 8 * fq;
            f32x4 WG[2][3], WV[2][3]; float rsa[2][4];
#pragma unroll
            for (int n = 0; n < 2; ++n)
#pragma unroll
                for (int k = 0; k < 3; ++k) { WG[n][k] = *(const f32x4*)(cw + k * 11264 + cbase + 4 * n); WV[n][k] = *(const f32x4*)(cw + k * 11264 + 5632 + cbase + 4 * n); }
#pragma unroll
            for (int ai = 0; ai < 2; ++ai)
#pragma unroll
                for (int m = 0; m < 4; ++m) rsa[ai][m] = ssp_in[row0 + ai * HALF + m * 16];
#pragma unroll
            for (int ai = 0; ai < 2; ++ai) {
                float rs[4];
#pragma unroll
                for (int m = 0; m < 4; ++m) rs[m] = __builtin_amdgcn_rsqf(rsa[ai][m] * (1.0f / 2048.0f) + 1e-6f);
                unsigned op[2][4][2];
#pragma unroll
                for (int n = 0; n < 2; ++n) {
                    const f32x4 wg0 = WG[n][0], wg1 = WG[n][1], wg2 = WG[n][2], wv0 = WV[n][0], wv1 = WV[n][1], wv2 = WV[n][2];
#pragma unroll
                    for (int jp = 0; jp < 2; ++jp) {
                        const f32x2 g0 = {wg0[2 * jp], wg0[2 * jp + 1]}, g1 = {wg1[2 * jp], wg1[2 * jp + 1]}, g2 = {wg2[2 * jp], wg2[2 * jp + 1]};
                        const f32x2 h0 = {wv0[2 * jp], wv0[2 * jp + 1]}, h1 = {wv1[2 * jp], wv1[2 * jp + 1]}, h2 = {wv2[2 * jp], wv2[2 * jp + 1]};
                        f32x2 cg[4], cv[4];
                        { f32x2 x[4];
#pragma unroll
                          for (int m = 0; m < 4; ++m) x[m] = (f32x2){acc[ai][0][m][n][2 * jp], acc[ai][0][m][n][2 * jp + 1]} * rs[m];
                          f32x2 q1 = {0.f, 0.f}, q2 = {0.f, 0.f};
#pragma unroll
                          for (int m = 0; m < 4; ++m) { f32x2 x1, x2; x1.x = shr_keep<1>(q1.x, x[m].x); x1.y = shr_keep<1>(q1.y, x[m].y); x2.x = shr_keep<2>(q2.x, x[m].x); x2.y = shr_keep<2>(q2.y, x[m].y);
                              cg[m] = g0 * x2 + g1 * x1 + g2 * x[m]; if (m < 3) { q1.x = ror1(x[m].x); q1.y = ror1(x[m].y); q2.x = ror2(x[m].x); q2.y = ror2(x[m].y); } } }
                        { f32x2 y[4];
#pragma unroll
                          for (int m = 0; m < 4; ++m) y[m] = (f32x2){acc[ai][1][m][n][2 * jp], acc[ai][1][m][n][2 * jp + 1]} * rs[m];
                          f32x2 q1 = {0.f, 0.f}, q2 = {0.f, 0.f};
#pragma unroll
                          for (int m = 0; m < 4; ++m) { f32x2 y1, y2; y1.x = shr_keep<1>(q1.x, y[m].x); y1.y = shr_keep<1>(q1.y, y[m].y); y2.x = shr_keep<2>(q2.x, y[m].x); y2.y = shr_keep<2>(q2.y, y[m].y);
                              cv[m] = h0 * y2 + h1 * y1 + h2 * y[m]; if (m < 3) { q1.x = ror1(y[m].x); q1.y = ror1(y[m].y); q2.x = ror2(y[m].x); q2.y = ror2(y[m].y); } } }
#pragma unroll
                        for (int m = 0; m < 4; ++m) { f32x2 sg; sg.x = __builtin_amdgcn_rcpf(1.0f + __expf(-cg[m].x)); sg.y = __builtin_amdgcn_rcpf(1.0f + __expf(-cg[m].y));
                            const f32x2 o = cg[m] * sg * cv[m]; op[n][m][jp] = cvt_pk_bf16(o.x, o.y); }
                        __builtin_amdgcn_sched_barrier(0);
                    }
                }
#pragma unroll
                for (int m = 0; m < 4; ++m) { const size_t row = (size_t)(row0 + ai * HALF + m * 16);
                    if (m > 0 || fr >= 2) { u32x4 w; w.x = op[0][m][0]; w.y = op[0][m][1]; w.z = op[1][m][0]; w.w = op[1][m][1]; *(u32x4*)(O + row * 5632 + cbase) = w; }
                    if ((m == 0 && fr < 2) || (m == 3 && fr >= 14)) { const f32x4 xg0 = acc[ai][0][m][0] * rs[m], xg1 = acc[ai][0][m][1] * rs[m], yv0 = acc[ai][1][m][0] * rs[m], yv1 = acc[ai][1][m][1] * rs[m];
                        u32x4 w; w.x = cvt_pk_bf16(xg0[0], xg0[1]); w.y = cvt_pk_bf16(xg0[2], xg0[3]); w.z = cvt_pk_bf16(xg1[0], xg1[1]); w.w = cvt_pk_bf16(xg1[2], xg1[3]); *(u32x4*)(Ub + row * 11264 + cbase) = w;
                        w.x = cvt_pk_bf16(yv0[0], yv0[1]); w.y = cvt_pk_bf16(yv0[2], yv0[3]); w.z = cvt_pk_bf16(yv1[0], yv1[1]); w.w = cvt_pk_bf16(yv1[2], yv1[3]); *(u32x4*)(Ub + row * 11264 + 5632 + cbase) = w; } }
                __builtin_amdgcn_sched_barrier(0);
            }
        } else if constexpr (mode == 4) {
            if (u.pn & 4) {
                const int t = 16 + (u.pn >> 3) * 4 + (u.pn & 3); const bool isv = t < 24; bf16_t* base = isv ? V : G; const int col0 = ((t - 16) & 7) * BM + wc * 32 + 8 * fq;
#pragma unroll
                for (int ai = 0; ai < 2; ++ai)
#pragma unroll
                    for (int m = 0; m < 4; ++m) { bf16_t* rowp = base + (size_t)(row0 + ai * HALF + m * 16) * 2048 + col0;
#pragma unroll
                        for (int bj = 0; bj < 2; ++bj) { f32x4 v0 = acc[ai][bj][m][0], v1 = acc[ai][bj][m][1];
                            if (!isv) {
#pragma unroll
                                for (int j = 0; j < 4; ++j) { v0[j] = v0[j] * __builtin_amdgcn_rcpf(1.0f + __expf(-v0[j])); v1[j] = v1[j] * __builtin_amdgcn_rcpf(1.0f + __expf(-v1[j])); } }
                            u32x4 w; w.x = cvt_pk_bf16(v0[0], v0[1]); w.y = cvt_pk_bf16(v0[2], v0[3]); w.z = cvt_pk_bf16(v1[0], v1[1]); w.w = cvt_pk_bf16(v1[2], v1[3]);
                            *(u32x4*)(rowp + bj * HALF) = w; } }
            } else {
                const int h = (u.pn >> 3) * 4 + (u.pn & 3), cl = wc * 32 + 8 * fq;
                f32x4 lb[2];
#pragma unroll
                for (int n = 0; n < 2; ++n) { const float* p = lbt + h * 128 + cl + 4 * n; const f32x4 t0 = *(const f32x4*)p, t1 = *(const f32x4*)(p + 2048), t2 = *(const f32x4*)(p + 4096);
#pragma unroll
                    for (int j = 0; j < 4; ++j) { const float mx = fmaxf(t0[j], fmaxf(t1[j], t2[j])); const float e0 = __expf(t0[j] - mx), e1 = __expf(t1[j] - mx), e2 = __expf(t2[j] - mx); lb[n][j] = e0 / (e0 + e1 + e2); } }
#pragma unroll
                for (int ai = 0; ai < 2; ++ai) {
                    const int m0 = u.pm * BM + ai * HALF + wr * 64;
                    const int task = ((m0 >> 12) * 16 + h) * 64 + ((m0 & 4095) >> 6);
                    unsigned qp[2][4][2], kp[2][4][2];
#pragma unroll
                    for (int n = 0; n < 2; ++n) {
                        f32x4 er, ebr, dec;
#pragma unroll
                        for (int jp = 0; jp < 2; ++jp) {
                            float qo[4][2], ko[4][2];
#pragma unroll
                            for (int e = 0; e < 2; ++e) { const int j = jp * 2 + e; const float l = lb[n][j];
                                float kk[4], bb[4];
#pragma unroll
                                for (int m = 0; m < 4; ++m) { const float a = acc[ai][1][m][n][j]; const float sg = __builtin_amdgcn_rcpf(1.0f + __expf(-a)); const float f = l + (1.0f - l) * sg; kk[m] = 1.0f - f;
                                    float s = __builtin_amdgcn_logf(f) * 0.6931471805599453f;     s += shr_dpp<1>(s); s += shr_dpp<2>(s); s += shr_dpp<4>(s); s += shr_dpp<8>(s); bb[m] = s; }
                                const float t0 = bc15_dpp(bb[0]), t1 = bc15_dpp(bb[1]), t2 = bc15_dpp(bb[2]), t3 = bc15_dpp(bb[3]);
                                const float c1 = t0 + t1; bb[1] += t0; bb[2] += c1; bb[3] += c1 + t2; const float bl = (c1 + t2) + t3;
                                const float r = c1;
#pragma unroll
                                for (int m = 0; m < 4; ++m) { const float aq = acc[ai][0][m][n][j]; const float qv = aq * __builtin_amdgcn_rcpf(1.0f + __expf(-aq)) * 0.08838834764831845f; const float e1 = __expf(bb[m] - r);
                                    qo[m][e] = qv * e1; ko[m][e] = kk[m] * __builtin_amdgcn_rcpf(e1); }
                                er[j] = __expf(r); ebr[j] = __expf(bl - r); dec[j] = __expf(bl);
                            }
#pragma unroll
                            for (int m = 0; m < 4; ++m) { qp[n][m][jp] = cvt_pk_bf16(qo[m][0], qo[m][1]); kp[n][m][jp] = cvt_pk_bf16(ko[m][0], ko[m][1]); }
                        }
                        if (fr == 0) { float* vp = LOGF + (size_t)task * 128 + cl + 4 * n; *(f32x4*)vp = er; *(f32x4*)(vp + 2048 * 128) = ebr; *(f32x4*)(vp + 2 * 2048 * 128) = dec; }
                        __builtin_amdgcn_sched_barrier(0);
                    }
#pragma unroll
                    for (int m = 0; m < 4; ++m) { const size_t off = (size_t)(row0 + ai * HALF + m * 16) * 2048 + h * 128 + cl;
                        u32x4 w; w.x = qp[0][m][0]; w.y = qp[0][m][1]; w.z = qp[1][m][0]; w.w = qp[1][m][1]; *(u32x4*)(Q + off) = w;
                        w.x = kp[0][m][0]; w.y = kp[0][m][1]; w.z = kp[1][m][0]; w.w = kp[1][m][1]; *(u32x4*)(KE + off) = w; }
                }
            }
        } else {
            const int sec = u.pn >> 3, col0 = (u.pn & 7) * BM + wc * 32 + 8 * fq;
            if (sec == 2) {
#pragma unroll
                for (int ai = 0; ai < 2; ++ai)
#pragma unroll
                    for (int m = 0; m < 4; ++m) { bf16_t* rowp = V + (size_t)(row0 + ai * HALF + m * 16) * 2048 + col0;
#pragma unroll
                        for (int bj = 0; bj < 2; ++bj) { const f32x4 v0 = acc[ai][bj][m][0], v1 = acc[ai][bj][m][1];
                            u32x4 w; w.x = cvt_pk_bf16(v0[0], v0[1]); w.y = cvt_pk_bf16(v0[2], v0[3]); w.z = cvt_pk_bf16(v1[0], v1[1]); w.w = cvt_pk_bf16(v1[2], v1[3]);
                            *(u32x4*)(rowp + bj * HALF) = w; } }
            } else if (sec == 1) {
                f32x4 lb[2][2];
#pragma unroll
                for (int bj = 0; bj < 2; ++bj)
#pragma unroll
                    for (int n = 0; n < 2; ++n) { const float* p = lbt + col0 + bj * HALF + 4 * n; const f32x4 t0 = *(const f32x4*)p, t1 = *(const f32x4*)(p + 2048), t2 = *(const f32x4*)(p + 4096);
#pragma unroll
                        for (int j = 0; j < 4; ++j) { const float mx = fmaxf(t0[j], fmaxf(t1[j], t2[j])); const float e0 = __expf(t0[j] - mx), e1 = __expf(t1[j] - mx), e2 = __expf(t2[j] - mx); lb[bj][n][j] = e0 / (e0 + e1 + e2); } }
#pragma unroll
                for (int ai = 0; ai < 2; ++ai)
#pragma unroll
                    for (int m = 0; m < 4; ++m) { float* rowp = LOGF + (size_t)(row0 + ai * HALF + m * 16) * 2048 + col0;
#pragma unroll
                        for (int bj = 0; bj < 2; ++bj)
#pragma unroll
                            for (int n = 0; n < 2; ++n) { f32x4 o;
#pragma unroll
                                for (int j = 0; j < 4; ++j) { const float a = acc[ai][bj][m][n][j]; const float sg = __builtin_amdgcn_rcpf(1.0f + __expf(-a)); const float l = lb[bj][n][j]; o[j] = __logf(l + (1.0f - l) * sg); }
                                *(f32x4*)(rowp + bj * HALF + 4 * n) = o; } }
            } else {
                bf16_t* base = sec == 0 ? Q : G; const float sc = sec == 0 ? 0.08838834764831845f : 1.0f;
#pragma unroll
                for (int ai = 0; ai < 2; ++ai)
#pragma unroll
                    for (int m = 0; m < 4; ++m) { bf16_t* rowp = base + (size_t)(row0 + ai * HALF + m * 16) * 2048 + col0;
#pragma unroll
                        for (int bj = 0; bj < 2; ++bj) { f32x4 v0 = acc[ai][bj][m][0], v1 = acc[ai][bj][m][1];
#pragma unroll
                            for (int j = 0; j < 4; ++j) { v0[j] = v0[j] * sc * __builtin_amdgcn_rcpf(1.0f + __expf(-v0[j])); v1[j] = v1[j] * sc * __builtin_amdgcn_rcpf(1.0f + __expf(-v1[j])); }
                            u32x4 w; w.x = cvt_pk_bf16(v0[0], v0[1]); w.y = cvt_pk_bf16(v0[2], v0[3]); w.z = cvt_pk_bf16(v1[0], v1[1]); w.w = cvt_pk_bf16(v1[2], v1[3]);
                            *(u32x4*)(rowp + bj * HALF) = w; } }
            }
        }
    }
};

template <class Epi, class Sched, bool ALIGN_EPI = false, bool SP2 = false>
__device__ __forceinline__ void gemm_phase(PG8_LAS unsigned char* lds, const Gemm g, const Sched& S, const Epi& E, const int wid) {
    int lane_; asm volatile("v_mbcnt_lo_u32_b32 %0, -1, 0\n\tv_mbcnt_hi_u32_b32 %0, -1, %0" : "=v"(lane_));
    const int lane = lane_, tid = wid * 64 + lane, wr = wid >> 2, wc = wid & 3, fr = lane & 15, fq = lane >> 4;
    constexpr int K = Epi::KC, nt = K / BK;
    unsigned voffA[2], voffB[2];
#pragma unroll
    for (int i = 0; i < 2; ++i) { int R, C; stage_rc(tid * 16 + i * 8192, R, C); const int Rb = Epi::PERM ? ((R & ~31) + perm32(R & 31)) : R;
        voffA[i] = (unsigned)(R * K + C) * 2u; voffB[i] = (unsigned)(Rb * K + C) * 2u; }
    const size_t kstep = (size_t)(BK * 2);
    const size_t hstep = (size_t)HALF * K * 2;
    const size_t tstep = 2 * hstep;
    const unsigned ldsw = (unsigned)wid * 1024u;
    const int aoff = lds_byte(wr * 64 + fr, fq * 8), boff = lds_byte(wc * 32 + fr, fq * 8);
#define PG8_SA(b, h) (((b) * 2 + (h)) * HTB)
#define PG8_SB(b, h) ((4 + (b) * 2 + (h)) * HTB)
#define PG8_STAGE(bufoff, gbase, voff) do { _Pragma("unroll") for (int _i = 0; _i < 2; ++_i) \
        __builtin_amdgcn_global_load_lds((const unsigned*)((const char*)(gbase) + (voff)[_i]), (PG8_LAS unsigned*)(lds + (bufoff) + ldsw + _i * 8192), 16, 0, 0); } while (0)
#define PG8_LDA(dst, b, h) do { _Pragma("unroll") for (int m = 0; m < 4; ++m) _Pragma("unroll") for (int k = 0; k < 2; ++k) dst[m][k] = *(const PG8_LAS bf16x8*)(lds + PG8_SA(b, h) + aoff + m * 2048 + k * 1024); } while (0)
#define PG8_LDB(dst, b, h) do { _Pragma("unroll") for (int n = 0; n < 2; ++n) _Pragma("unroll") for (int k = 0; k < 2; ++k) dst[n][k] = *(const PG8_LAS bf16x8*)(lds + PG8_SB(b, h) + boff + n * 2048 + k * 1024); } while (0)
#define PG8_MMA(ai, bj, At, Bt) do { __builtin_amdgcn_s_setprio(1); _Pragma("unroll") for (int m = 0; m < 4; ++m) _Pragma("unroll") for (int n = 0; n < 2; ++n) _Pragma("unroll") for (int k = 0; k < 2; ++k) \
        acc[ai][bj][m][n] = __builtin_amdgcn_mfma_f32_16x16x32_bf16(Bt[n][k], At[m][k], acc[ai][bj][m][n], 0, 0, 0); __builtin_amdgcn_s_setprio(0); } while (0)
#define PG8_WAIT_V(n) asm volatile("s_waitcnt vmcnt(" #n ")" ::: "memory")
#define PG8_WAIT_L(n) asm volatile("s_waitcnt lgkmcnt(" #n ")" ::: "memory")
#define PG8_BAR __builtin_amdgcn_s_barrier()
#define PG8_SCHED __builtin_amdgcn_sched_barrier(0)
    Unit cur, nxt; int ui = 0;
    if (!S.next(0, cur)) return;
    f32x4 acc[2][2][4][2];
#pragma unroll
    for (int a = 0; a < 2; ++a)
#pragma unroll
        for (int b = 0; b < 2; ++b)
#pragma unroll
            for (int m = 0; m < 4; ++m)
#pragma unroll
                for (int n = 0; n < 2; ++n) acc[a][b][m][n] = (f32x4){0.f, 0.f, 0.f, 0.f};
    bf16x8 At[4][2], B0[2][2], B1[2][2];
    const char* cA = (const char*)g.A + (size_t)cur.pm * tstep; const char* cB = (const char*)g.Bt + (size_t)cur.pn * tstep;
    S.a_ready(cur);
    if constexpr (SP2) {
        PG8_STAGE(PG8_SB(0, 0), cB, voffB); PG8_STAGE(PG8_SB(0, 1), cB + hstep, voffB); PG8_STAGE(PG8_SA(0, 0), cA, voffA); PG8_STAGE(PG8_SA(0, 1), cA + hstep, voffA);
        if (wr == 1) PG8_BAR;
        PG8_WAIT_V(2); PG8_BAR;
        PG8_STAGE(PG8_SB(1, 0), cB + kstep, voffB); PG8_STAGE(PG8_SA(1, 0), cA + kstep, voffA); PG8_STAGE(PG8_SB(1, 1), cB + hstep + kstep, voffB);
        PG8_WAIT_V(6); PG8_BAR;
    } else {
        PG8_STAGE(PG8_SB(0, 0), cB, voffB); PG8_STAGE(PG8_SA(0, 0), cA, voffA); PG8_STAGE(PG8_SB(0, 1), cB + hstep, voffB); PG8_STAGE(PG8_SA(0, 1), cA + hstep, voffA);
        if (wr == 1) PG8_BAR;
        PG8_WAIT_V(4); PG8_BAR;
        PG8_STAGE(PG8_SB(1, 0), cB + kstep, voffB); PG8_STAGE(PG8_SA(1, 0), cA + kstep, voffA); PG8_STAGE(PG8_SB(1, 1), cB + hstep + kstep, voffB);
        PG8_WAIT_V(6); PG8_BAR;
    }
    for (;;) {
        const bool has_next = S.next(ui + 1, nxt);
        const char* nA = has_next ? (const char*)g.A + (size_t)nxt.pm * tstep : cA; const char* nB = has_next ? (const char*)g.Bt + (size_t)nxt.pn * tstep : cB;
        for (int t = 0; t < nt; t += 2) {
            const bool last = (t == nt - 2);
            const char* a1 = cA + (size_t)(t + 1) * kstep;
            const char* a2 = last ? nA : cA + (size_t)(t + 2) * kstep; const char* b2 = last ? nB : cB + (size_t)(t + 2) * kstep;
            const char* a3 = a2 + kstep; const char* b3 = b2 + kstep;
            if (last && has_next) S.a_ready(nxt);
            if constexpr (SP2) {
            PG8_LDB(B0, 0, 0); PG8_LDB(B1, 0, 1); PG8_SCHED; PG8_LDA(At, 0, 0); PG8_STAGE(PG8_SA(1, 1), a1 + hstep, voffA);
            PG8_WAIT_V(8); PG8_WAIT_L(0); PG8_BAR; PG8_MMA(0, 0, At, B0); PG8_MMA(0, 1, At, B1); PG8_BAR; PG8_SCHED;
            PG8_LDA(At, 0, 1); PG8_STAGE(PG8_SB(0, 0), b2, voffB); PG8_STAGE(PG8_SB(0, 1), b2 + hstep, voffB); PG8_STAGE(PG8_SA(0, 0), a2, voffA);
            PG8_WAIT_V(8); PG8_WAIT_L(0); PG8_BAR; PG8_MMA(1, 0, At, B0); PG8_MMA(1, 1, At, B1); PG8_BAR; PG8_SCHED;
            PG8_LDB(B0, 1, 0); PG8_LDB(B1, 1, 1); PG8_SCHED; PG8_LDA(At, 1, 0); PG8_STAGE(PG8_SA(0, 1), a2 + hstep, voffA);
            PG8_WAIT_V(8); PG8_WAIT_L(0); PG8_BAR; PG8_MMA(0, 0, At, B0); PG8_MMA(0, 1, At, B1); PG8_BAR; PG8_SCHED;
            PG8_LDA(At, 1, 1); PG8_STAGE(PG8_SB(1, 0), b3, voffB); PG8_STAGE(PG8_SB(1, 1), b3 + hstep, voffB); PG8_STAGE(PG8_SA(1, 0), a3, voffA);
            PG8_WAIT_V(8); PG8_WAIT_L(0); PG8_BAR; PG8_MMA(1, 0, At, B0); PG8_MMA(1, 1, At, B1); PG8_BAR; PG8_SCHED;
            } else {
            PG8_LDB(B0, 0, 0); PG8_SCHED; PG8_LDA(At, 0, 0); PG8_STAGE(PG8_SA(1, 1), a1 + hstep, voffA);
            PG8_WAIT_L(8); PG8_BAR; PG8_WAIT_L(0); PG8_MMA(0, 0, At, B0); PG8_BAR; PG8_SCHED;
            PG8_LDB(B1, 0, 1); PG8_STAGE(PG8_SB(0, 0), b2, voffB);
            PG8_BAR; PG8_WAIT_L(0); PG8_MMA(0, 1, At, B1); PG8_BAR;
            PG8_LDA(At, 0, 1); PG8_STAGE(PG8_SA(0, 0), a2, voffA);
            PG8_BAR; PG8_WAIT_L(0); PG8_MMA(1, 0, At, B0); PG8_BAR; PG8_SCHED;
            PG8_STAGE(PG8_SB(0, 1), b2 + hstep, voffB);
            PG8_WAIT_V(6); PG8_BAR; PG8_MMA(1, 1, At, B1); PG8_BAR;
            PG8_LDB(B0, 1, 0); PG8_SCHED; PG8_LDA(At, 1, 0); PG8_STAGE(PG8_SA(0, 1), a2 + hstep, voffA);
            PG8_WAIT_L(8); PG8_BAR; PG8_WAIT_L(0); PG8_MMA(0, 0, At, B0); PG8_BAR; PG8_SCHED;
            PG8_LDB(B1, 1, 1); PG8_STAGE(PG8_SB(1, 0), b3, voffB);
            PG8_BAR; PG8_WAIT_L(0); PG8_MMA(0, 1, At, B1); PG8_BAR;
            PG8_LDA(At, 1, 1); PG8_STAGE(PG8_SA(1, 0), a3, voffA);
            PG8_BAR; PG8_WAIT_L(0); PG8_MMA(1, 0, At, B0); PG8_BAR; PG8_SCHED;
            PG8_STAGE(PG8_SB(1, 1), b3 + hstep, voffB);
            PG8_WAIT_V(6); PG8_BAR; PG8_MMA(1, 1, At, B1); PG8_BAR;
            }
        }
        if constexpr (ALIGN_EPI) { if (wr == 0) PG8_BAR; }
        if constexpr (!Epi::AFTER_DRAIN) { E(acc, cur, wr, wc, fr, fq); S.done(cur); }
        if (!has_next) break;
#pragma unroll
        for (int a = 0; a < 2; ++a)
#pragma unroll
            for (int b = 0; b < 2; ++b)
#pragma unroll
                for (int m = 0; m < 4; ++m)
#pragma unroll
                    for (int n = 0; n < 2; ++n) acc[a][b][m][n] = (f32x4){0.f, 0.f, 0.f, 0.f};
        cur = nxt; cA = nA; cB = nB; ++ui;
        if constexpr (ALIGN_EPI) { if (wr == 1) PG8_BAR; }
    }
    PG8_WAIT_V(0);
    if constexpr (!ALIGN_EPI) { if (wr == 0) PG8_BAR; }
    PG8_BAR;
    if constexpr (Epi::AFTER_DRAIN) { E.fused(acc, cur, wr, wc, fr, fq, lds, wid, lane); S.done(cur); }
#undef PG8_SA
#undef PG8_SB
#undef PG8_STAGE
#undef PG8_LDA
#undef PG8_LDB
#undef PG8_MMA
#undef PG8_WAIT_V
#undef PG8_WAIT_L
#undef PG8_BAR
#undef PG8_SCHED
}
}

#define LAS __attribute__((address_space(3)))
typedef unsigned short bf16;
typedef short bf16x8 __attribute__((ext_vector_type(8)));
typedef float f32x4 __attribute__((ext_vector_type(4)));
typedef unsigned u32x4 __attribute__((ext_vector_type(4)));
typedef unsigned u32x2 __attribute__((ext_vector_type(2)));
constexpr int NWAVES = 8, NTHR = 512;
constexpr int SEQ = 4096, D = 2048, M = 8192, HD = 128, FF = 5632, NIN = 8192, NSC = 6144, NUP = 11264;
constexpr int NTASK = 2048;
constexpr float EPS = 1e-6f;
constexpr int LDS_BYTES = 147456;

constexpr size_t MiB = 1u << 20;
constexpr size_t WS_WIN = 1 * MiB, WS_WOH = WS_WIN + 32 * MiB, WS_WUP0 = WS_WOH + 8 * MiB, WS_WUP1 = WS_WUP0 + 44 * MiB, WS_WDN0 = WS_WUP1 + 44 * MiB, WS_WDN1 = WS_WDN0 + 22 * MiB,
                 WS_WSI = WS_WDN1 + 22 * MiB, WS_WSO = WS_WSI + 24 * MiB, WS_XN = WS_WSO + 8 * MiB, WS_R = WS_XN + 32 * MiB;
constexpr size_t WS_Q = WS_R, WS_LOGF = WS_Q + 32 * MiB  , WS_V = WS_LOGF + 64 * MiB  , WS_G = WS_V + 32 * MiB, WS_UT = WS_G + 32 * MiB, WS_SP = WS_UT + 128 * MiB,
                 WS_DEC = WS_SP + 64 * MiB, WS_SS = WS_DEC + 1 * MiB, WS_R_END = WS_SS + 1 * MiB;
constexpr size_t WS_U = WS_R, WS_ACT = WS_U + 176 * MiB;
constexpr size_t WS_P2 = WS_R, WS_Y = WS_P2 + 96 * MiB;
constexpr size_t WS_SSP = WS_R_END, WS_QE2 = WS_SSP + 1 * MiB, WS_OI = WS_QE2 + 32 * MiB, WS_END = WS_OI + 64 * MiB;
static_assert(WS_ACT + 88 * MiB <= WS_END && WS_Y + 32 * MiB <= WS_END, "ws map");

typedef __bf16 bf16x2_t __attribute__((ext_vector_type(2)));
__device__ __forceinline__ unsigned pk_bf16(float lo, float hi) { bf16x2_t v = {(__bf16)lo, (__bf16)hi}; return __builtin_bit_cast(unsigned, v); }
__device__ __forceinline__ float bf_lo(unsigned w) { return __uint_as_float(w << 16); }
__device__ __forceinline__ float bf_hi(unsigned w) { return __uint_as_float(w & 0xffff0000u); }
__device__ __forceinline__ float bf1(bf16 h) { return __uint_as_float(((unsigned)h) << 16); }
__device__ __forceinline__ float wave_sum(float v) {
#pragma unroll
    for (int o = 1; o < 64; o <<= 1) v += __shfl_xor(v, o);
    return v;
}
__device__ __forceinline__ int lane_id() { int l; asm volatile("v_mbcnt_lo_u32_b32 %0, -1, 0\n\tv_mbcnt_hi_u32_b32 %0, -1, %0" : "=v"(l)); return l; }
__device__ __forceinline__ float silu_f(float a) { return a * __builtin_amdgcn_rcpf(1.0f + __expf(-a)); }

__device__ __forceinline__ int hg_pos(int idx, int b0) { return 8 * (idx >> 2) + b0 + (idx & 3); }
struct CvtItem { const float* W; bf16* WT; const float* wk; int K, N, item; int perm; };
__device__ __forceinline__ void cvt_load(const CvtItem& d, int lane, f32x4 (&v)[8]) {
    const int nblk = d.N / 32, kb = d.item / nblk, nb = d.item % nblk, k0 = 64 * kb, n0 = 32 * nb;
#pragma unroll
    for (int i = 0; i < 8; ++i) { const int kk = i * 8 + (lane >> 3); v[i] = __builtin_nontemporal_load((const f32x4*)(d.W + (size_t)(k0 + kk) * d.N + n0 + 4 * (lane & 7))); }
}
__device__ __forceinline__ void cvt_store(const CvtItem& d, int lane, const f32x4 (&v)[8], LAS float* scr) {
    const int nblk = d.N / 32, kb = d.item / nblk, nb = d.item % nblk, k0 = 64 * kb, n0 = 32 * nb;
    const int r0 = d.perm == 1 ? (n0 < FF ? (n0 >> 7) * 256 + (n0 & 127) : ((n0 - FF) >> 7) * 256 + 128 + ((n0 - FF) & 127))
                 : d.perm == 2 ? (n0 < 2048 ? hg_pos(n0 >> 7, 0) * 256 + (n0 & 127) : (n0 < 4096 ? hg_pos((n0 - 2048) >> 7, 0) * 256 + 128 + ((n0 - 2048) & 127) : hg_pos((n0 >> 8) - 16, 4) * 256 + (n0 & 255))) : n0;
#pragma unroll
    for (int i = 0; i < 8; ++i) { const int kk = i * 8 + (lane >> 3); LAS float* dd = scr + kk * 33 + 4 * (lane & 7); dd[0] = v[i][0]; dd[1] = v[i][1]; dd[2] = v[i][2]; dd[3] = v[i][3]; }
    asm volatile("s_waitcnt lgkmcnt(0)" ::: "memory");
    const int c = lane & 7;
    f32x4 wa = {1.f, 1.f, 1.f, 1.f}, wb = {1.f, 1.f, 1.f, 1.f};
    if (d.wk) { wa = *(const f32x4*)(d.wk + k0 + 8 * c); wb = *(const f32x4*)(d.wk + k0 + 8 * c + 4); }
#pragma unroll
    for (int j = 0; j < 4; ++j) { const int n = (lane >> 3) + 8 * j; const LAS float* s = scr + (8 * c) * 33 + n;
        u32x4 o; o.x = pk_bf16(s[0 * 33] * wa[0], s[1 * 33] * wa[1]); o.y = pk_bf16(s[2 * 33] * wa[2], s[3 * 33] * wa[3]); o.z = pk_bf16(s[4 * 33] * wb[0], s[5 * 33] * wb[1]); o.w = pk_bf16(s[6 * 33] * wb[2], s[7 * 33] * wb[3]);
        *(u32x4*)(d.WT + (size_t)(r0 + n) * d.K + k0 + 8 * c) = o; }
    asm volatile("s_waitcnt lgkmcnt(0)" ::: "memory");
}
constexpr int I_IN = (D / 64) * (NIN / 32), I_OH = (D / 64) * (D / 32), I_UP = (D / 64) * (NUP / 32), I_DN = (FF / 64) * (D / 32), I_SI = (D / 64) * (NSC / 32), I_SO = I_OH;
constexpr int P0_ITEMS = I_IN + I_OH + I_UP + I_DN + I_SI + I_SO, T3_ITEMS = I_UP + I_DN;
struct CvtSrc { const float *hin, *hout, *up, *dn, *si, *so, *nffn, *nmix; unsigned char* ws; };
__device__ __forceinline__ CvtItem p0_item(const CvtSrc& s, int r) {
    if (r < I_IN) return CvtItem{s.hin, (bf16*)(s.ws + WS_WIN), nullptr, D, NIN, r, 2}; r -= I_IN;
    if (r < I_OH) return CvtItem{s.hout, (bf16*)(s.ws + WS_WOH), nullptr, D, D, r, 0}; r -= I_OH;
    if (r < I_UP) return CvtItem{s.up, (bf16*)(s.ws + WS_WUP0), s.nffn, D, NUP, r, 1}; r -= I_UP;
    if (r < I_DN) return CvtItem{s.dn, (bf16*)(s.ws + WS_WDN0), nullptr, FF, D, r, 0}; r -= I_DN;
    if (r < I_SI) return CvtItem{s.si, (bf16*)(s.ws + WS_WSI), s.nmix + D, D, NSC, r, 0}; r -= I_SI;
    return CvtItem{s.so, (bf16*)(s.ws + WS_WSO), nullptr, D, D, r, 0};
}
__device__ __forceinline__ CvtItem t3_item(const CvtSrc& s, int r) {
    if (r < I_UP) return CvtItem{s.up + (size_t)D * NUP, (bf16*)(s.ws + WS_WUP1), s.nffn + D, D, NUP, r, 1};
    return CvtItem{s.dn + (size_t)FF * D, (bf16*)(s.ws + WS_WDN1), nullptr, FF, D, r - I_UP, 0};
}
template <bool T3> __device__ __forceinline__ void cvt_run(const CvtSrc& s, int first, int stride, int nitems, LAS float* scr, int lane) {
    if (first >= nitems) return;
    f32x4 cur[8], nxt[8];
    CvtItem dc = T3 ? t3_item(s, first) : p0_item(s, first);
    cvt_load(dc, lane, cur);
    for (int it = first; it < nitems; it += stride) {
        const bool more = it + stride < nitems;
        CvtItem dn = dc;
        if (more) { dn = T3 ? t3_item(s, it + stride) : p0_item(s, it + stride); cvt_load(dn, lane, nxt); }
        cvt_store(dc, lane, cur, scr);
        if (more) {
#pragma unroll
            for (int i = 0; i < 8; ++i) cur[i] = nxt[i];
            dc = dn; }
    }
}

__device__ __forceinline__ void rms_row_bf16(const float* xrow, const float* w, bf16* orow, int lane) {
    const f32x4* xr = (const f32x4*)xrow + lane; const f32x4* wr = (const f32x4*)w + lane;
    f32x4 v[8]; float s = 0.f;
#pragma unroll
    for (int j = 0; j < 8; ++j) { v[j] = __builtin_nontemporal_load(xr + 64 * j); s += (v[j][0] * v[j][0] + v[j][1] * v[j][1]) + (v[j][2] * v[j][2] + v[j][3] * v[j][3]); }
    f32x4 gg[8];
#pragma unroll
    for (int j = 0; j < 8; ++j) gg[j] = wr[64 * j];
    const float rstd = __builtin_amdgcn_rsqf(wave_sum(s) * (1.0f / D) + EPS);
    u32x2* o8 = (u32x2*)orow + lane;
#pragma unroll
    for (int j = 0; j < 8; ++j) { const f32x4 g = gg[j]; u32x2 o; o.x = pk_bf16(v[j][0] * rstd * g[0], v[j][1] * rstd * g[1]); o.y = pk_bf16(v[j][2] * rstd * g[2], v[j][3] * rstd * g[3]); o8[64 * j] = o; }
}
__device__ __forceinline__ void rms_row_f32(const float* xrow, const float* w, float* orow, int lane) {
    const f32x4* xr = (const f32x4*)xrow + lane; const f32x4* wr = (const f32x4*)w + lane;
    f32x4 v[8]; float s = 0.f;
#pragma unroll
    for (int j = 0; j < 8; ++j) { v[j] = xr[64 * j]; s += (v[j][0] * v[j][0] + v[j][1] * v[j][1]) + (v[j][2] * v[j][2] + v[j][3] * v[j][3]); }
    const float rstd = __builtin_amdgcn_rsqf(wave_sum(s) * (1.0f / D) + EPS);
    f32x4* o = (f32x4*)orow + lane;
#pragma unroll
    for (int j = 0; j < 8; ++j) { const f32x4 g = wr[64 * j]; o[64 * j] = v[j] * rstd * g; }
}

__device__ __forceinline__ void unpack8(const u32x4 w, float (&f)[8]) { f[0] = bf_lo(w.x); f[1] = bf_hi(w.x); f[2] = bf_lo(w.y); f[3] = bf_hi(w.y); f[4] = bf_lo(w.z); f[5] = bf_hi(w.z); f[6] = bf_lo(w.w); f[7] = bf_hi(w.w); }
__device__ __forceinline__ void load8f(const float* p, float (&f)[8]) { const f32x4 a = *(const f32x4*)p, b = *(const f32x4*)(p + 4); f[0] = a[0]; f[1] = a[1]; f[2] = a[2]; f[3] = a[3]; f[4] = b[0]; f[5] = b[1]; f[6] = b[2]; f[7] = b[3]; }
template <int RS, int SEGSTRIDE> __device__ __forceinline__ void conv_glu_phase(const bf16* U, const float* cw  , bf16* ACT, int gtid, int gthreads) {
    constexpr int NCG = FF / 8, NSEG = M / SEGSTRIDE;
    for (int it = gtid; it < NCG * NSEG; it += gthreads) {
        const int jg = it % NCG, seg = it / NCG, c0 = jg * 8, t0 = seg * SEGSTRIDE;
        const bool first = (t0 & (SEQ - 1)) == 0;
        u32x4 rg[RS + 2], rv[RS + 2];
        const bf16* up = U + (size_t)(first ? t0 : t0 - 2) * NUP + c0;
#pragma unroll
        for (int r = 0; r < RS + 2; ++r) { const size_t o = (size_t)(first ? (r < 2 ? 0 : r - 2) : r) * NUP; rg[r] = *(const u32x4*)(up + o); rv[r] = *(const u32x4*)(up + o + FF); }
        float wg[3][8], wv[3][8];
#pragma unroll
        for (int k = 0; k < 3; ++k) { load8f(cw + k * NUP + c0, wg[k]); load8f(cw + k * NUP + FF + c0, wv[k]); }
        float g2[8], g1[8], v2[8], v1[8];
        unpack8(rg[0], g2); unpack8(rg[1], g1); unpack8(rv[0], v2); unpack8(rv[1], v1);
        if (first) {
#pragma unroll
            for (int j = 0; j < 8; ++j) { g2[j] = 0.f; g1[j] = 0.f; v2[j] = 0.f; v1[j] = 0.f; }
        }
#pragma unroll
        for (int r = 0; r < RS; ++r) {
            float g0[8], v0[8];
            unpack8(rg[r + 2], g0); unpack8(rv[r + 2], v0);
            float o[8];
#pragma unroll
            for (int j = 0; j < 8; ++j) { const float cgv = wg[0][j] * g2[j] + wg[1][j] * g1[j] + wg[2][j] * g0[j]; const float cvv = wv[0][j] * v2[j] + wv[1][j] * v1[j] + wv[2][j] * v0[j];
                o[j] = silu_f(cgv) * cvv; g2[j] = g1[j]; g1[j] = g0[j]; v2[j] = v1[j]; v1[j] = v0[j]; }
            u32x4 w; w.x = pk_bf16(o[0], o[1]); w.y = pk_bf16(o[2], o[3]); w.z = pk_bf16(o[4], o[5]); w.w = pk_bf16(o[6], o[7]);
            *(u32x4*)(ACT + (size_t)(t0 + r) * FF + c0) = w;
        }
    }
}
__device__ __forceinline__ void short_conv_phase(const bf16* P2, const float* cw  , bf16* Y, int gtid, int gthreads) {
    constexpr int NCG = D / 8, RS = 8, NSEG = M / RS;
    for (int it = gtid; it < NCG * NSEG; it += gthreads) {
        const int jg = it % NCG, seg = it / NCG, c0 = jg * 8, t0 = seg * RS;
        const bool first = (t0 & (SEQ - 1)) == 0;
        u32x4 rc[RS + 2], rh[RS + 2];
        const bf16* pp = P2 + (size_t)(first ? t0 : t0 - 2) * NSC + c0;
#pragma unroll
        for (int r = 0; r < RS + 2; ++r) { const size_t o = (size_t)(first ? (r < 2 ? 0 : r - 2) : r) * NSC; rc[r] = *(const u32x4*)(pp + o + D); rh[r] = *(const u32x4*)(pp + o + 2 * D); }
        u32x4 rb[RS];
#pragma unroll
        for (int r = 0; r < 4; ++r) rb[r] = *(const u32x4*)(P2 + (size_t)(t0 + r) * NSC + c0);
        float w3[3][8];
#pragma unroll
        for (int k = 0; k < 3; ++k) load8f(cw + k * D + c0, w3[k]);
        float z2[8], z1[8];
        { float a[8], b[8]; unpack8(rc[0], a); unpack8(rh[0], b);
#pragma unroll
          for (int j = 0; j < 8; ++j) z2[j] = first ? 0.f : a[j] * b[j];
          unpack8(rc[1], a); unpack8(rh[1], b);
#pragma unroll
          for (int j = 0; j < 8; ++j) z1[j] = first ? 0.f : a[j] * b[j]; }
#pragma unroll
        for (int r = 0; r < RS; ++r) {
            float gb[8], a[8], b[8], o[8];
            if (r == 2) {
#pragma unroll
                for (int q = 4; q < RS; ++q) rb[q] = *(const u32x4*)(P2 + (size_t)(t0 + q) * NSC + c0); }
            unpack8(rb[r], gb); unpack8(rc[r + 2], a); unpack8(rh[r + 2], b);
#pragma unroll
            for (int j = 0; j < 8; ++j) { const float z0 = a[j] * b[j]; o[j] = gb[j] * (w3[0][j] * z2[j] + w3[1][j] * z1[j] + w3[2][j] * z0); z2[j] = z1[j]; z1[j] = z0; }
            u32x4 w; w.x = pk_bf16(o[0], o[1]); w.y = pk_bf16(o[2], o[3]); w.z = pk_bf16(o[4], o[5]); w.w = pk_bf16(o[6], o[7]);
            *(u32x4*)(Y + (size_t)(t0 + r) * D + c0) = w;
        }
    }
}

__device__ __forceinline__ f32x4 mma_t(const bf16x8 a, const bf16x8 b, const f32x4 c) { return __builtin_amdgcn_mfma_f32_16x16x32_bf16(b, a, c, 0, 0, 0); }
constexpr int KT_LD = 72;
constexpr int R1_KET = 0, R1_VT = R1_KET + 128 * KT_LD * 2, R1_AM = R1_VT + 128 * KT_LD * 2, R1_END = R1_AM + 64 * KT_LD * 2;
static_assert(R1_END <= 131072, "R1 LDS");

__device__ __forceinline__ void r1_phase(unsigned char* lds, const bf16* QE, const bf16* KE, const bf16* V, bf16* OINTRA, bf16* UT, int nblk, int blk, const int wid, const int lane) {
    const int tid = wid * 64 + lane, fr = lane & 15, fq = lane >> 4;
    bf16* sKET = (bf16*)(lds + R1_KET); bf16* sVT = (bf16*)(lds + R1_VT); bf16* sAM = (bf16*)(lds + R1_AM);
    const int seg = tid >> 7, d = tid & 127;
    unsigned short kn[16], vn[16];
    if (blk < NTASK) { const int bh = blk >> 6, c = blk & 63, b_ = bh >> 4, h = bh & 15, m0 = b_ * SEQ + c * 64; const size_t gb = (size_t)(m0 + seg * 16) * D + h * HD + d;
#pragma unroll
        for (int i = 0; i < 16; ++i) { kn[i] = KE[gb + (size_t)i * D]; vn[i] = V[gb + (size_t)i * D]; } }
    for (int task = blk; task < NTASK; task += nblk) {
        const int bh = task >> 6, c = task & 63, b_ = bh >> 4, h = bh & 15, m0 = b_ * SEQ + c * 64;
        bf16x8 fa[2][4], fb[2][4];
#pragma unroll
        for (int q = 0; q < 2; ++q) { const int id = wid * 2 + q, ti = id >> 2, sj = id & 3;
            if (sj <= ti) {
#pragma unroll
                for (int kk = 0; kk < 4; ++kk) { fa[q][kk] = *(const bf16x8*)(QE + (size_t)(m0 + ti * 16 + fr) * D + h * HD + kk * 32 + fq * 8); fb[q][kk] = *(const bf16x8*)(KE + (size_t)(m0 + sj * 16 + fr) * D + h * HD + kk * 32 + fq * 8); } } }
        { u32x4 w0, w1;
          w0.x = kn[0] | ((unsigned)kn[1] << 16); w0.y = kn[2] | ((unsigned)kn[3] << 16); w0.z = kn[4] | ((unsigned)kn[5] << 16); w0.w = kn[6] | ((unsigned)kn[7] << 16);
          w1.x = kn[8] | ((unsigned)kn[9] << 16); w1.y = kn[10] | ((unsigned)kn[11] << 16); w1.z = kn[12] | ((unsigned)kn[13] << 16); w1.w = kn[14] | ((unsigned)kn[15] << 16);
          *(u32x4*)(sKET + d * KT_LD + seg * 16) = w0; *(u32x4*)(sKET + d * KT_LD + seg * 16 + 8) = w1;
          w0.x = vn[0] | ((unsigned)vn[1] << 16); w0.y = vn[2] | ((unsigned)vn[3] << 16); w0.z = vn[4] | ((unsigned)vn[5] << 16); w0.w = vn[6] | ((unsigned)vn[7] << 16);
          w1.x = vn[8] | ((unsigned)vn[9] << 16); w1.y = vn[10] | ((unsigned)vn[11] << 16); w1.z = vn[12] | ((unsigned)vn[13] << 16); w1.w = vn[14] | ((unsigned)vn[15] << 16);
          *(u32x4*)(sVT + d * KT_LD + seg * 16) = w0; *(u32x4*)(sVT + d * KT_LD + seg * 16 + 8) = w1; }
        if (task + nblk < NTASK) { const int tn = task + nblk, bhn = tn >> 6, cn = tn & 63, bn = bhn >> 4, hn = bhn & 15, m0n = bn * SEQ + cn * 64; const size_t gb = (size_t)(m0n + seg * 16) * D + hn * HD + d;
#pragma unroll
            for (int i = 0; i < 16; ++i) { kn[i] = KE[gb + (size_t)i * D]; vn[i] = V[gb + (size_t)i * D]; } }
#pragma unroll
        for (int q = 0; q < 2; ++q) { const int id = wid * 2 + q, ti = id >> 2, sj = id & 3; f32x4 acc = {0.f, 0.f, 0.f, 0.f};
            if (sj <= ti) {
#pragma unroll
                for (int kk = 0; kk < 4; ++kk) acc = mma_t(fa[q][kk], fb[q][kk], acc);
                const int t = ti * 16 + fr, s0 = sj * 16 + 4 * fq;
#pragma unroll
                for (int j = 0; j < 4; ++j) if (s0 + j > t) acc[j] = 0.f;
            }
            u32x2 w; w.x = pk_bf16(acc[0], acc[1]); w.y = pk_bf16(acc[2], acc[3]);
            *(u32x2*)(sAM + (ti * 16 + fr) * KT_LD + sj * 16 + 4 * fq) = w; }
        __syncthreads();
        { const bf16x8 a0 = *(const bf16x8*)(sVT + (wid * 16 + fr) * KT_LD + fq * 8), a1 = *(const bf16x8*)(sVT + (wid * 16 + fr) * KT_LD + 32 + fq * 8);
          bf16* up = UT + (size_t)task * 16384 + (size_t)(wid * 16 + fr) * 128 + 4 * fq;
#pragma unroll
          for (int dj = 0; dj < 8; ++dj) { const bf16x8 b0 = *(const bf16x8*)(sKET + (dj * 16 + fr) * KT_LD + fq * 8), b1 = *(const bf16x8*)(sKET + (dj * 16 + fr) * KT_LD + 32 + fq * 8);
              f32x4 acc = {0.f, 0.f, 0.f, 0.f}; acc = mma_t(a0, b0, acc); acc = mma_t(a1, b1, acc); u32x2 w; w.x = pk_bf16(acc[0], acc[1]); w.y = pk_bf16(acc[2], acc[3]); *(u32x2*)(up + dj * 16) = w; } }
        { const int ti = wid >> 1; const bf16x8 a0 = *(const bf16x8*)(sAM + (ti * 16 + fr) * KT_LD + fq * 8), a1 = *(const bf16x8*)(sAM + (ti * 16 + fr) * KT_LD + 32 + fq * 8);
          bf16* op = OINTRA + (size_t)(m0 + ti * 16 + fr) * D + h * HD + 4 * fq;
#pragma unroll
          for (int q = 0; q < 4; ++q) { const int vj = (wid & 1) * 4 + q; const bf16x8 b0 = *(const bf16x8*)(sVT + (vj * 16 + fr) * KT_LD + fq * 8), b1 = *(const bf16x8*)(sVT + (vj * 16 + fr) * KT_LD + 32 + fq * 8);
              f32x4 acc = {0.f, 0.f, 0.f, 0.f}; acc = mma_t(a0, b0, acc); acc = mma_t(a1, b1, acc); u32x2 w; w.x = pk_bf16(acc[0], acc[1]); w.y = pk_bf16(acc[2], acc[3]); *(u32x2*)(op + vj * 16) = w; } }
        __syncthreads();
    }
}
__device__ __forceinline__ void r2_phase(const bf16* UT, const float* VEC, bf16* SP, int gtid, int gthreads) {
    for (int e = gtid; e < 32 * 4096; e += gthreads) {
        const int bh = e >> 12, rem = e & 4095, d4 = (rem & 31) * 4;
        f32x4 S = {0.f, 0.f, 0.f, 0.f};
        for (int c0 = 0; c0 < 64; c0 += 8) {
            u32x2 uw[8]; f32x4 er[8], ebr[8], dc[8];
#pragma unroll
            for (int i = 0; i < 8; ++i) { const size_t task = (size_t)bh * 64 + c0 + i;
                uw[i] = *(const u32x2*)(UT + task * 16384 + (size_t)rem * 4);
                er[i] = *(const f32x4*)(VEC + task * 128 + d4); ebr[i] = *(const f32x4*)(VEC + 2048 * 128 + task * 128 + d4); dc[i] = *(const f32x4*)(VEC + 2 * 2048 * 128 + task * 128 + d4); }
#pragma unroll
            for (int i = 0; i < 8; ++i) { const size_t task = (size_t)bh * 64 + c0 + i;
                const f32x4 Sp = S * er[i];
                u32x2 w; w.x = pk_bf16(Sp[0], Sp[1]); w.y = pk_bf16(Sp[2], Sp[3]); *(u32x2*)(SP + task * 16384 + (size_t)rem * 4) = w;
                const f32x4 u = {bf_lo(uw[i].x), bf_hi(uw[i].x), bf_lo(uw[i].y), bf_hi(uw[i].y)};
                S = dc[i] * S + ebr[i] * u; }
        }
    }
}
struct R3Set { bf16x8 a[4]; bf16x8 b[4][4]; u32x2 oi[4]; u32x2 g[4]; };
__device__ __forceinline__ void r3_load(R3Set& s, int un, const bf16* QE2, const bf16* SP, const bf16* OINTRA, const bf16* G, int fr, int fq) {
    const int task = un >> 3, ti = (un >> 1) & 3, half = un & 1, bh = task >> 6, c = task & 63, b_ = bh >> 4, h = bh & 15, row = b_ * SEQ + c * 64 + ti * 16 + fr;
    const bf16* ap = QE2 + (size_t)row * D + h * HD + fq * 8;
#pragma unroll
    for (int kk = 0; kk < 4; ++kk) s.a[kk] = *(const bf16x8*)(ap + kk * 32);
    const bf16* sp = SP + (size_t)task * 16384 + (size_t)(half * 64 + fr) * 128 + fq * 8; const size_t obase = (size_t)row * D + h * HD + half * 64 + 4 * fq;
#pragma unroll
    for (int q = 0; q < 4; ++q) { s.oi[q] = *(const u32x2*)(OINTRA + obase + q * 16); s.g[q] = *(const u32x2*)(G + obase + q * 16);
#pragma unroll
        for (int kk = 0; kk < 4; ++kk) s.b[q][kk] = *(const bf16x8*)(sp + (size_t)q * 16 * 128 + kk * 32); }
}
__device__ __forceinline__ void r3_phase(const bf16* QE2, const bf16* SP, const bf16* OINTRA, const bf16* G, const float* gain, bf16* OG, float* SSO, int gw, int ngw, int lane) {
    const int fr = lane & 15, fq = lane >> 4;
    R3Set cur, nxt;
    if (gw < NTASK * 8) r3_load(cur, gw, QE2, SP, OINTRA, G, fr, fq);
    for (int un = gw; un < NTASK * 8; un += ngw) {
        const bool more = un + ngw < NTASK * 8;
        if (more) r3_load(nxt, un + ngw, QE2, SP, OINTRA, G, fr, fq);
        const int task = un >> 3, ti = (un >> 1) & 3, half = un & 1, bh = task >> 6, c = task & 63, b_ = bh >> 4, h = bh & 15, row = b_ * SEQ + c * 64 + ti * 16 + fr;
        const size_t obase = (size_t)row * D + h * HD + half * 64 + 4 * fq;
        float ssum = 0.f;
#pragma unroll
        for (int q = 0; q < 4; ++q) { f32x4 acc = {bf_lo(cur.oi[q].x), bf_hi(cur.oi[q].x), bf_lo(cur.oi[q].y), bf_hi(cur.oi[q].y)};
            const f32x4 gn = *(const f32x4*)(gain + h * HD + half * 64 + q * 16 + 4 * fq);
#pragma unroll
            for (int kk = 0; kk < 4; ++kk) acc = mma_t(cur.a[kk], cur.b[q][kk], acc);
            ssum += (acc[0] * acc[0] + acc[1] * acc[1]) + (acc[2] * acc[2] + acc[3] * acc[3]);
            u32x2 w; w.x = pk_bf16(acc[0] * gn[0] * bf_lo(cur.g[q].x), acc[1] * gn[1] * bf_hi(cur.g[q].x)); w.y = pk_bf16(acc[2] * gn[2] * bf_lo(cur.g[q].y), acc[3] * gn[3] * bf_hi(cur.g[q].y));
            *(u32x2*)(OG + obase + q * 16) = w; }
        ssum += __shfl_xor(ssum, 16); ssum += __shfl_xor(ssum, 32);
        if (fq == 0) unsafeAtomicAdd(SSO + row, ssum);
        if (more) cur = nxt;
    }
}

#define XB_TMO      128
#define XB_XCNT(j)  (256  + 64 * (j))
#define XB_XSUB(j)  (1280 + 64 * (j))
#define XB_XGEN(j)  (2304 + 64 * (j))
#define XB_TOP      3328
#define XB_TOPGEN   3392
#define XCD_BAR_WORDS 3456
#define XB_SPIN_CAP (1u << 20)
__device__ __forceinline__ unsigned xb_ld(unsigned* p)              { return __hip_atomic_load(p, __ATOMIC_RELAXED, __HIP_MEMORY_SCOPE_AGENT); }
__device__ __forceinline__ unsigned xb_add(unsigned* p, unsigned v) { return __hip_atomic_fetch_add(p, v, __ATOMIC_RELAXED, __HIP_MEMORY_SCOPE_AGENT); }
__device__ __forceinline__ unsigned xb_xcc_id() { return (unsigned)__builtin_amdgcn_s_getreg((3 << 11) | 20) & 0xFu; }
#define XB_SPIN(cond, bar) do { unsigned _sp = 0; while (cond) { __builtin_amdgcn_s_sleep(1); \
    if ((++_sp & 255u) == 0u) { if (xb_ld(&(bar)[XB_TMO])) break; if (_sp > XB_SPIN_CAP) { atomicAdd(&(bar)[XB_TMO], 1u); break; } } } } while (0)
__device__ __forceinline__ void xcd_barrier_complete(unsigned* bar, unsigned x, unsigned G, unsigned& nloc, unsigned& nx) {
    unsigned sum, cnt, mine, sp = 0u;
    for (;;) {
        sum = 0u; cnt = 0u; mine = 0u;
#pragma unroll
        for (unsigned j = 0; j < 16; ++j) { const unsigned c = xb_ld(&bar[XB_XCNT(j)]); sum += c; cnt += (c > 0u) ? 1u : 0u; mine = (j == x) ? c : mine; }
        if (sum == G) break;
        __builtin_amdgcn_s_sleep(1);
        if ((++sp & 255u) == 0u) { if (xb_ld(&bar[XB_TMO])) break; if (sp > XB_SPIN_CAP) { atomicAdd(&bar[XB_TMO], 1u); break; } }
    }
    nloc = mine > 0u ? mine : 1u; nx = cnt > 0u ? cnt : 1u;
}
__device__ __forceinline__ void xcd_barrier(unsigned* bar, volatile LAS unsigned* st, int wave, unsigned G) {
    asm volatile("s_waitcnt vmcnt(0)" ::: "memory");
    __syncthreads();
    if (wave == 0 && lane_id() == 0) {
        const unsigned x = xb_xcc_id();
        __builtin_amdgcn_s_waitcnt(0);
        unsigned nloc = st[0], nx = st[1];
        if (nloc == 0u) { xcd_barrier_complete(bar, x, G, nloc, nx); st[0] = nloc; st[1] = nx; }
        const unsigned old = xb_add(&bar[XB_XSUB(x)], 1u);
        const unsigned gen = old / nloc;
        if (old + 1u == (gen + 1u) * nloc) {
            __builtin_amdgcn_fence(__ATOMIC_RELEASE, "agent");
            asm volatile("s_waitcnt vmcnt(0)" ::: "memory");
            const unsigned og = xb_add(&bar[XB_TOP], 1u);
            const unsigned tg = og / nx;
            if (og + 1u == (tg + 1u) * nx) xb_add(&bar[XB_TOPGEN], 1u);
            else XB_SPIN(xb_ld(&bar[XB_TOPGEN]) == tg, bar);
            __builtin_amdgcn_fence(__ATOMIC_ACQUIRE, "agent");
            xb_add(&bar[XB_XGEN(x)], 1u);
            asm volatile("s_waitcnt vmcnt(0)" ::: "memory");
        } else {
            XB_SPIN(xb_ld(&bar[XB_XGEN(x)]) == gen, bar);
            __builtin_amdgcn_fence(__ATOMIC_ACQUIRE, "agent");
            asm volatile("s_waitcnt vmcnt(0)" ::: "memory");
        }
    }
    __syncthreads();
}

enum { PH_P0 = 0, PH_G1, PH_R1, PH_R2, PH_R3, PH_G2, PH_N1, PH_G3, PH_C1, PH_G4, PH_N2, PH_G5, PH_C2, PH_G6, PH_N3, PH_G7, PH_C3, PH_G8, PH_FN, NPH };
struct Args { const float* in[14]; float* out; unsigned char* ws; int ph_lo, ph_hi; };

__global__ void __launch_bounds__(NTHR, 2) trunk_fwd(Args args) {
    extern __shared__ __attribute__((aligned(16))) unsigned char lds[];
    const int wave = __builtin_amdgcn_readfirstlane(threadIdx.x >> 6);
    const int G_ = gridDim.x, blk = blockIdx.x, ngw = G_ * NWAVES, gthreads = G_ * NTHR;
#define LANE_SETUP() int lane = lane_id(); asm volatile("" : "+v"(lane)); const int tid = wave * 64 + lane, gw = blk * NWAVES + wave, gtid = blk * NTHR + tid; (void)tid; (void)gw; (void)gtid
    unsigned char* ws = args.ws;
    float* H = args.out;
    bf16* XN = (bf16*)(ws + WS_XN);
    const int lo = args.ph_lo, hi = args.ph_hi;
#define IN(k) (lo <= (k) && (k) < hi)
    if (lo < 0) cg::this_grid().sync();
    volatile LAS unsigned* bst = (volatile LAS unsigned*)((LAS unsigned char*)lds + 131072 + 1024);
    unsigned* bar = (unsigned*)ws;
    {
        if (wave == 0) { const int l0 = lane_id(); if (l0 < 2) bst[l0] = 0u; if (l0 == 0) (void)xb_add(&bar[XB_XCNT(xb_xcc_id())], 1u); }
        __syncthreads();
    }
#define SEAM(k) do { xcd_barrier(bar, bst, wave, (unsigned)G_); } while (0)
#define RUN_GEMM(MODE, KC, Aptr, Bptr, NN, SETUP) do { pg8::Gemm g{(const bf16*)(Aptr), (const bf16*)(Bptr), M, (NN), (KC)}; pg8::Epi<MODE, KC> E{}; SETUP; \
        pg8::StaticOrder S; S.init(M, (NN), G_, blk); pg8::gemm_phase<pg8::Epi<MODE, KC>, pg8::StaticOrder, true, true>((LAS unsigned char*)lds, g, S, E, wave); } while (0)
    { LANE_SETUP();
        LAS float* scr = (LAS float*)((LAS unsigned char*)lds + wave * 16384);
        { const CvtSrc cs{args.in[3], args.in[6], args.in[10], args.in[12], args.in[7], args.in[9], args.in[2], args.in[1], ws};
          cvt_run<false>(cs, gw, ngw, P0_ITEMS, scr, lane); }
        for (int m = gw; m < M; m += ngw) rms_row_bf16(args.in[0] + (size_t)m * D, args.in[1], XN + (size_t)m * D, lane);
        for (int i = gtid; i < 5 * M; i += gthreads) ((float*)(ws + WS_SSP))[i] = 0.f;
        SEAM(PH_P0);
    }
#pragma nounroll
    for (int L = 0; L < 2; ++L) {
        if (L == 0) {
            RUN_GEMM(4, 2048, XN, ws + WS_WIN, NIN, (E.Q = (bf16*)(ws + WS_Q), E.KE = (bf16*)(ws + WS_LOGF), E.LOGF = (float*)(ws + WS_LOGF + 32 * MiB), E.V = (bf16*)(ws + WS_V), E.G = (bf16*)(ws + WS_G), E.lbt = args.in[4]));
            SEAM(PH_G1);
            { LANE_SETUP();
              r1_phase(lds, (const bf16*)(ws + WS_Q), (const bf16*)(ws + WS_LOGF), (const bf16*)(ws + WS_V), (bf16*)(ws + WS_OI), (bf16*)(ws + WS_UT), G_, blk, wave, lane); }
            SEAM(PH_R1);
            { LANE_SETUP();
              r2_phase((const bf16*)(ws + WS_UT), (const float*)(ws + WS_LOGF + 32 * MiB), (bf16*)(ws + WS_SP), gtid, gthreads); }
            SEAM(PH_R2);
            { LANE_SETUP();
              r3_phase((const bf16*)(ws + WS_Q), (const bf16*)(ws + WS_SP), (const bf16*)(ws + WS_OI), (const bf16*)(ws + WS_G), args.in[5], (bf16*)(ws + WS_V), (float*)(ws + WS_SSP) + 3 * M, gw, ngw, lane); }
            SEAM(PH_R3);
        } else {
            RUN_GEMM(0, 2048, XN, ws + WS_WSI, NSC, (E.O = (bf16*)(ws + WS_P2), E.ldc = NSC, E.ssp_in = (const float*)(ws + WS_SSP) + 1 * M));
            SEAM(PH_G5);
            { LANE_SETUP();
              short_conv_phase((const bf16*)(ws + WS_P2), args.in[8], (bf16*)(ws + WS_Y), gtid, gthreads); }
            SEAM(PH_C2);
        }
        RUN_GEMM(1, 2048, ws + (L ? WS_Y : WS_V), ws + (L ? WS_WSO : WS_WOH), D, (E.out = nullptr, E.res = args.in[0], E.resb = L ? (const bf16*)XN : (const bf16*)nullptr, E.ss = L ? (const float*)nullptr : (const float*)(ws + WS_SSP) + 3 * M, E.hb = XN, E.ssp_out = (float*)(ws + WS_SSP) + (L ? 2 * M : 0)));
        SEAM(PH_G2);
        RUN_GEMM(3, 2048, XN, ws + (L ? WS_WUP1 : WS_WUP0), NUP, (E.O = (bf16*)(ws + WS_ACT), E.Ub = (bf16*)(ws + WS_U), E.cw = args.in[11] + (L ? 3 * NUP : 0), E.ssp_in = (const float*)(ws + WS_SSP) + (L ? 2 * M : 0)));
        if (L == 0) {
            const int nrem = ((NUP / 256) * (M / 256)) % G_, first_idle = nrem, nconv = G_ - first_idle;
            if (blk >= first_idle) { LANE_SETUP();
                LAS float* scr = (LAS float*)((LAS unsigned char*)lds + wave * 16384);
                const CvtSrc cs{args.in[3], args.in[6], args.in[10], args.in[12], args.in[7], args.in[9], args.in[2], args.in[1], ws};
                cvt_run<true>(cs, (blk - first_idle) * NWAVES + wave, nconv * NWAVES, T3_ITEMS, scr, lane); }
        }
        SEAM(PH_G3);
        { LANE_SETUP();
          conv_glu_phase<2, 64>((const bf16*)(ws + WS_U), args.in[11] + (L ? 3 * NUP : 0), (bf16*)(ws + WS_ACT), gtid, gthreads); }
        SEAM(PH_C1);
        RUN_GEMM(1, 5632, ws + WS_ACT, ws + (L ? WS_WDN1 : WS_WDN0), D, (E.out = nullptr, E.res = nullptr, E.resb = XN, E.ss = nullptr, E.hb = XN, E.ssp_out = (float*)(ws + WS_SSP) + (L ? 4 * M : 1 * M)));
        SEAM(PH_G4);
    }
    { LANE_SETUP();
        const float* ssq = (const float*)(ws + WS_SSP) + 4 * M; const f32x4* wr = (const f32x4*)args.in[13];
        for (int it = gtid; it < M * (D / 8); it += gthreads) { const int row = it >> 8, c8 = (it & 255) * 8;
            const u32x4 hw = __builtin_nontemporal_load((const u32x4*)(XN + (size_t)row * D + c8)); const float rstd = __builtin_amdgcn_rsqf(ssq[row] * (1.0f / D) + EPS);
            const f32x4 g0 = wr[c8 >> 2], g1 = wr[(c8 >> 2) + 1];
            f32x4 o0 = {bf_lo(hw.x), bf_hi(hw.x), bf_lo(hw.y), bf_hi(hw.y)}, o1 = {bf_lo(hw.z), bf_hi(hw.z), bf_lo(hw.w), bf_hi(hw.w)};
            o0 = o0 * rstd * g0; o1 = o1 * rstd * g1;
            f32x4* op = (f32x4*)(H + (size_t)row * D + c8); __builtin_nontemporal_store(o0, op); __builtin_nontemporal_store(o1, op + 1); }
    }
#undef IN
#undef LANE_SETUP
#undef SEAM
#undef RUN_GEMM
}

extern "C" void kernel_launch(void* const* d_in, const int* in_sizes, int n_in, void* d_out, int out_size, void* d_ws, size_t ws_size, hipStream_t stream) {
    static int grid = 0;
    if (grid == 0) {
        if (n_in != 14 || in_sizes[0] != M * D || out_size != M * D || ws_size < WS_END) { fprintf(stderr, "kernel_launch: unexpected shapes (n_in %d, in0 %d, out %d, ws %zu < %zu)\n", n_in, n_in > 0 ? in_sizes[0] : -1, out_size, ws_size, (size_t)WS_END); grid = -1; return; }
        int dev = 0, cus = 0, per_cu = 0;
        if (hipGetDevice(&dev) != hipSuccess || hipDeviceGetAttribute(&cus, hipDeviceAttributeMultiprocessorCount, dev) != hipSuccess) { grid = -1; return; }
        if (hipFuncSetAttribute((const void*)trunk_fwd, hipFuncAttributeMaxDynamicSharedMemorySize, LDS_BYTES) != hipSuccess) { fprintf(stderr, "kernel_launch: hipFuncSetAttribute failed\n"); grid = -1; return; }
        if (hipOccupancyMaxActiveBlocksPerMultiprocessor(&per_cu, (const void*)trunk_fwd, NTHR, LDS_BYTES) != hipSuccess || per_cu < 1) { fprintf(stderr, "kernel_launch: occupancy query says %d\n", per_cu); per_cu = 1; }
        (void)hipGetLastError();
        grid = cus * 1;
    }
    if (grid < 0) return;
    if (hipMemsetAsync(d_ws, 0, 16384, stream) != hipSuccess) { fprintf(stderr, "kernel_launch: memset failed\n"); return; }
    Args a{};
    for (int i = 0; i < 14; ++i) a.in[i] = (const float*)d_in[i];
    a.out = (float*)d_out; a.ws = (unsigned char*)d_ws;
#if MK_SINGLE
    a.ph_lo = 0; a.ph_hi = NPH;
    void* kargs[] = {&a};
    hipError_t e = hipLaunchCooperativeKernel((const void*)trunk_fwd, dim3(grid), dim3(NTHR), kargs, LDS_BYTES, stream);
    if (e != hipSuccess) fprintf(stderr, "kernel_launch: cooperative launch failed: %s (grid %d)\n", hipGetErrorString(e), grid);
#else
    for (int p = 0; p < NPH; ++p) { a.ph_lo = p; a.ph_hi = p + 1; hipLaunchKernelGGL(trunk_fwd, dim3(grid), dim3(NTHR), LDS_BYTES, stream, a); }
#endif
}
```
